# Optimizing an MI355X kernel written in HIP

```python
import jax, jax.numpy as jnp
from jax import lax
import numpy as np

D_MODEL = 1024
BATCH = 8
SEQ = 4096
DEPTH = 4

N_A_LAYERS = DEPTH // 2
N_B_LAYERS = DEPTH - N_A_LAYERS
EPS = 1e-6

CHUNK = 128
A_WIDTH = 2 * D_MODEL
A_GROUP_WIDTH = 256
A_GROUPS = A_WIDTH // A_GROUP_WIDTH

HEAD_DIM = 128
DILATED_GROUPS = ((128, 1), (512, 4), (2048, 16))
N_GROUPS = len(DILATED_GROUPS)
Q_HEADS_PER_GROUP = D_MODEL // HEAD_DIM
KV_HEADS_PER_GROUP = 2
Q_PER_KV = Q_HEADS_PER_GROUP // KV_HEADS_PER_GROUP
N_Q_HEADS = N_GROUPS * Q_HEADS_PER_GROUP
N_KV_HEADS = N_GROUPS * KV_HEADS_PER_GROUP
B_WIDTH = Q_HEADS_PER_GROUP * HEAD_DIM
BAND = 128

kernel_name = "yoco_gmlp_dilated_hybrid"


def rms_norm(x, g):
    xf = x.astype(jnp.float32)
    y = xf * lax.rsqrt(jnp.mean(xf * xf, axis=-1, keepdims=True) + EPS)
    return (y * g.astype(jnp.float32)).astype(x.dtype)


def ada_mod(c, w, b, n):
    h = jax.nn.silu(c) @ w + b
    return jnp.split(h[:, None, :], n, axis=-1)


def alibi_slopes():
    h = jnp.arange(1, N_Q_HEADS + 1, dtype=jnp.float32)
    return jnp.exp2(-8.0 * h / N_Q_HEADS)


def to_dilated(t, d):
    b, s = t.shape[:2]
    rest = t.shape[2:]
    span = d * BAND
    sp = -(-s // span) * span
    t = jnp.pad(t, [(0, 0), (0, sp - s)] + [(0, 0)] * len(rest))
    t = t.reshape((b, sp // d, d) + rest)
    t = jnp.swapaxes(t, 1, 2)
    return t.reshape((b, d, sp // span, BAND) + rest)


def from_dilated(t, s):
    b, d, nb = t.shape[:3]
    rest = t.shape[4:]
    t = t.reshape((b, d, nb * BAND) + rest)
    t = jnp.swapaxes(t, 1, 2)
    return t.reshape((b, nb * BAND * d) + rest)[:, :s]


def band_keys(t):
    prev = jnp.pad(t[:, :, :-1], [(0, 0), (0, 0), (1, 0)] + [(0, 0)] * 3)
    return jnp.concatenate([prev, t], axis=3)


def gmlp_layer(x, c, ada_w, ada_b, norm_g, w_in, sgu_g, w_s, b_s, w_out):
    bsz, s, _ = x.shape
    shift, scale, gate = ada_mod(c, ada_w, ada_b, 3)
    h = rms_norm(x, norm_g) * (1 + scale) + shift
    u, v, z = jnp.split(h @ w_in, 3, axis=-1)
    u = jax.nn.gelu(u)
    v = rms_norm(jax.nn.gelu(v), sgu_g)
    v = v.reshape(bsz, s // CHUNK, CHUNK, A_GROUPS, A_GROUP_WIDTH)
    w_causal = jnp.tril(w_s)
    mixed = jnp.einsum('gts,bcsge->bctge', w_causal, v) + b_s.T[None, None, :, :, None]
    y = u * mixed.reshape(bsz, s, A_WIDTH) * jax.nn.silu(z)
    return x + gate * (y @ w_out)


def shared_kv(x, c, ada_w, ada_b, norm_g, w_kv, k_norm_g):
    bsz, s, _ = x.shape
    shift, scale = ada_mod(c, ada_w, ada_b, 2)
    h = rms_norm(x, norm_g) * (1 + scale) + shift
    k, v = jnp.split(h @ w_kv, 2, axis=-1)
    k = rms_norm(k.reshape(bsz, s, N_KV_HEADS, HEAD_DIM), k_norm_g)
    v = v.reshape(bsz, s, N_KV_HEADS, HEAD_DIM)
    groups = []
    for g, (window, d) in enumerate(DILATED_GROUPS):
        hs = slice(g * KV_HEADS_PER_GROUP, (g + 1) * KV_HEADS_PER_GROUP)
        groups.append((band_keys(to_dilated(k[:, :, hs], d)),
                       band_keys(to_dilated(v[:, :, hs], d))))
    return groups


def dilated_group_attn(q, kb, vb, slopes, window, d):
    s = q.shape[1]
    ql = to_dilated(q, d)
    bsz, _, nb = ql.shape[:3]
    ql = ql.reshape(bsz, d, nb, BAND, KV_HEADS_PER_GROUP, Q_PER_KV, HEAD_DIM)
    sc = jnp.einsum('brnikgh,brnjkh->brnkgij', ql, kb, preferred_element_type=jnp.float32)
    i = jnp.arange(BAND)[:, None]
    j = jnp.arange(2 * BAND)[None, :]
    dq = BAND + i - j
    key_idx = (jnp.arange(nb)[:, None, None] - 1) * BAND + j
    valid = (dq >= 0) & (dq <= window // d) & (key_idx >= 0)
    bias = -slopes.astype(jnp.float32).reshape(KV_HEADS_PER_GROUP, Q_PER_KV)[:, :, None, None] \
        * (d * dq).astype(jnp.float32)
    sc = jnp.where(valid[:, None, None], sc + bias, -jnp.inf)
    m = jnp.max(sc, axis=-1, keepdims=True)
    p = jnp.exp(sc - m)
    l = jnp.sum(p, axis=-1, keepdims=True)
    o = jnp.einsum('brnkgij,brnjkh->brnikgh', p / l, vb.astype(jnp.float32))
    lse = jnp.moveaxis((m + jnp.log(l))[..., 0], -1, 3)
    o = from_dilated(o.reshape(bsz, d, nb, BAND, Q_HEADS_PER_GROUP, HEAD_DIM), s)
    lse = from_dilated(lse.reshape(bsz, d, nb, BAND, Q_HEADS_PER_GROUP), s)
    return o, lse


def dilated_layer(x, c, kv_groups, ada_w, ada_b, norm_g, w_in, q_norm_g, w_out):
    bsz, s, _ = x.shape
    shift, scale, gate = ada_mod(c, ada_w, ada_b, 3)
    h = rms_norm(x, norm_g) * (1 + scale) + shift
    qz = h @ w_in
    q = qz[..., :N_Q_HEADS * HEAD_DIM].reshape(bsz, s, N_Q_HEADS, HEAD_DIM)
    z = qz[..., N_Q_HEADS * HEAD_DIM:]
    q = rms_norm(q, q_norm_g) * (HEAD_DIM ** -0.5)
    slopes = alibi_slopes()
    outs, lses = [], []
    for g, (window, d) in enumerate(DILATED_GROUPS):
        hs = slice(g * Q_HEADS_PER_GROUP, (g + 1) * Q_HEADS_PER_GROUP)
        kb, vb = kv_groups[g]
        o, lse = dilated_group_attn(q[:, :, hs], kb, vb, slopes[hs], window, d)
        outs.append(o)
        lses.append(lse)
    alpha = jax.nn.softmax(jnp.stack(lses), axis=0)
    o = jnp.sum(alpha[..., None] * jnp.stack(outs), axis=0).astype(x.dtype)
    y = o.reshape(bsz, s, B_WIDTH) * jax.nn.silu(z)
    return x + gate * (y @ w_out)


def setup_inputs(seed: int = 0) -> dict:
    key = jax.random.key(seed)
    ks = jax.random.split(key, 24)
    nrm = lambda k, shape, sc: jax.random.normal(k, shape, jnp.float32) * sc
    D = D_MODEL
    return {
        "x": nrm(ks[0], (BATCH, SEQ, D), 1.0),
        "c": nrm(ks[1], (BATCH, D), 1.0),
        "a_ada_w": nrm(ks[2], (N_A_LAYERS, D, 3 * D), 0.5 * D ** -0.5),
        "a_ada_b": nrm(ks[3], (N_A_LAYERS, 3 * D), 0.01),
        "a_norm_g": 1.0 + nrm(ks[4], (N_A_LAYERS, D), 0.05),
        "a_w_in": nrm(ks[5], (N_A_LAYERS, D, 3 * A_WIDTH), D ** -0.5),
        "a_sgu_g": 1.0 + nrm(ks[6], (N_A_LAYERS, A_WIDTH), 0.05),
        "a_w_spatial": nrm(ks[7], (N_A_LAYERS, A_GROUPS, CHUNK, CHUNK), 0.5 * CHUNK ** -0.5),
        "a_b_spatial": 1.0 + nrm(ks[8], (N_A_LAYERS, A_GROUPS, CHUNK), 0.01),
        "a_w_out": nrm(ks[9], (N_A_LAYERS, A_WIDTH, D), A_WIDTH ** -0.5),
        "kv_ada_w": nrm(ks[10], (D, 2 * D), 0.5 * D ** -0.5),
        "kv_ada_b": nrm(ks[11], (2 * D,), 0.01),
        "kv_norm_g": 1.0 + nrm(ks[12], (D,), 0.05),
        "w_kv": nrm(ks[13], (D, 2 * N_KV_HEADS * HEAD_DIM), D ** -0.5),
        "k_norm_g": 1.0 + nrm(ks[14], (HEAD_DIM,), 0.05),
        "b_ada_w": nrm(ks[15], (N_B_LAYERS, D, 3 * D), 0.5 * D ** -0.5),
        "b_ada_b": nrm(ks[16], (N_B_LAYERS, 3 * D), 0.01),
        "b_norm_g": 1.0 + nrm(ks[17], (N_B_LAYERS, D), 0.05),
        "b_w_in": nrm(ks[18], (N_B_LAYERS, D, N_Q_HEADS * HEAD_DIM + B_WIDTH), D ** -0.5),
        "b_q_norm_g": 1.0 + nrm(ks[19], (N_B_LAYERS, HEAD_DIM), 0.05),
        "b_w_out": nrm(ks[20], (N_B_LAYERS, B_WIDTH, D), B_WIDTH ** -0.5),
    }


def reference(x, c, a_ada_w, a_ada_b, a_norm_g, a_w_in, a_sgu_g, a_w_spatial, a_b_spatial,
              a_w_out, kv_ada_w, kv_ada_b, kv_norm_g, w_kv, k_norm_g, b_ada_w, b_ada_b,
              b_norm_g, b_w_in, b_q_norm_g, b_w_out):
    kv_groups = None
    for layer in range(DEPTH):
        if layer < N_A_LAYERS:
            x = gmlp_layer(x, c, a_ada_w[layer], a_ada_b[layer], a_norm_g[layer], a_w_in[layer],
                           a_sgu_g[layer], a_w_spatial[layer], a_b_spatial[layer], a_w_out[layer])
        else:
            if layer == N_A_LAYERS:
                kv_groups = shared_kv(x, c, kv_ada_w, kv_ada_b, kv_norm_g, w_kv, k_norm_g)
            lb = layer - N_A_LAYERS
            x = dilated_layer(x, c, kv_groups, b_ada_w[lb], b_ada_b[lb], b_norm_g[lb], b_w_in[lb],
                              b_q_norm_g[lb], b_w_out[lb])
    return x
```

```cpp
#include <hip/hip_runtime.h>
#include <hip/hip_cooperative_groups.h>
#include <cstdio>
namespace cg = cooperative_groups;

#define LAS __attribute__((address_space(3)))
typedef unsigned short bf16_t;
typedef short bf16x8 __attribute__((ext_vector_type(8)));
typedef float f32x4 __attribute__((ext_vector_type(4)));
typedef unsigned u32x4 __attribute__((ext_vector_type(4)));
typedef unsigned u32x2 __attribute__((ext_vector_type(2)));

constexpr int T = 32768, DM = 1024, SEQ = 4096;
constexpr int MODW = 14336;
constexpr float EPS = 1e-6f;
constexpr float LOG2E = 1.4426950408889634f;
constexpr float LN2 = 0.6931471805599453f;

constexpr size_t MiB = 1024 * 1024;
constexpr size_t WS_MOD  = 64 * 1024;
constexpr size_t WS_PART = 1 * MiB;
constexpr size_t WS_LSE  = 3 * MiB;
constexpr size_t WS_WVA  = 6 * MiB;
constexpr size_t WS_WUZ  = WS_WVA + 8 * MiB;
constexpr size_t WS_WOA  = WS_WUZ + 16 * MiB;
constexpr size_t WS_WKV  = WS_WOA + 8 * MiB;
constexpr size_t WS_WQB  = WS_WKV + 3 * MiB;
constexpr size_t WS_WOB  = WS_WQB + 16 * MiB;
constexpr size_t WS_BIG  = WS_WOB + 4 * MiB;
constexpr size_t WS_H    = WS_BIG;
constexpr size_t WS_BUF1 = WS_H + 64 * MiB;
constexpr size_t WS_BUF2 = WS_BUF1 + 128 * MiB;
constexpr size_t WS_QO   = WS_BIG;
constexpr size_t WS_KD   = WS_QO + 192 * MiB;
constexpr size_t WS_VT   = WS_KD + 48 * MiB;
constexpr size_t WS_ZS   = WS_VT + 48 * MiB;
constexpr size_t WS_HB   = WS_ZS + 64 * MiB;
constexpr size_t WS_END  = WS_HB + 64 * MiB;
constexpr int LDS_BYTES = 137216;

#ifndef PH_REP
#define PH_REP 0
#endif
#ifndef PH_MASK
#define PH_MASK 0xFFFF
#endif
struct Params { const float* in[21]; float* out; unsigned char* ws; int never; int pad; };

__device__ __forceinline__ unsigned cvt_pk_bf16(float lo, float hi) { unsigned r; asm volatile("v_cvt_pk_bf16_f32 %0, %1, %2" : "=v"(r) : "v"(lo), "v"(hi)); return r; }
__device__ __forceinline__ float bf_lo(unsigned w) { return __uint_as_float(w << 16); }
__device__ __forceinline__ float bf_hi(unsigned w) { return __uint_as_float(w & 0xffff0000u); }
__device__ __forceinline__ int opaque_tid(int wv) { int t; asm volatile("v_mbcnt_lo_u32_b32 %0, -1, 0\n\tv_mbcnt_hi_u32_b32 %0, -1, %0" : "=v"(t)); return (wv << 6) | t; }
__device__ __forceinline__ int opaque_bid() { int t = blockIdx.x; asm volatile("" : "+s"(t)); return t; }
#define dpp_f(x, ctrl) __builtin_bit_cast(float, __builtin_amdgcn_update_dpp(0, __builtin_bit_cast(int, (x)), (ctrl), 0xF, 0xF, true))
__device__ __forceinline__ float shx(float v, int mask, int lane) { return __builtin_bit_cast(float, __builtin_amdgcn_ds_bpermute((lane ^ mask) << 2, __builtin_bit_cast(int, v))); }
__device__ __forceinline__ float ex2(float x) { return __builtin_amdgcn_exp2f(x); }
__device__ __forceinline__ float silu_f(float x) { return x * __builtin_amdgcn_rcpf(1.0f + ex2(-LOG2E * x)); }
__device__ __forceinline__ float gelu_f(float x) {
    const float y = 0.7978845608028654f * (x + 0.044715f * x * x * x);
    return x * __builtin_amdgcn_rcpf(1.0f + ex2(-2.0f * LOG2E * y));
}

typedef float f32x2 __attribute__((ext_vector_type(2)));
constexpr float GC1 = -2.0f * 1.4426950408889634f * 0.7978845608028654f, GC3 = GC1 * 0.044715f;
__device__ __forceinline__ f32x2 gelu_arg2(f32x2 x) { return x * ((x * x) * GC3 + GC1); }
__device__ __forceinline__ f32x2 ex2_2(f32x2 a) { f32x2 r; r.x = __builtin_amdgcn_exp2f(a.x); r.y = __builtin_amdgcn_exp2f(a.y); return r; }
__device__ __forceinline__ f32x2 rcp_2(f32x2 a) { f32x2 r; r.x = __builtin_amdgcn_rcpf(a.x); r.y = __builtin_amdgcn_rcpf(a.y); return r; }
__device__ __forceinline__ f32x2 gelu_2(f32x2 x) { return x * rcp_2(ex2_2(gelu_arg2(x)) + 1.0f); }
__device__ __forceinline__ f32x2 gate_2(f32x2 u, f32x2 z, f32x2 m) {
    const f32x2 d = (ex2_2(gelu_arg2(u)) + 1.0f) * (ex2_2(z * (-LOG2E)) + 1.0f);
    return ((u * z) * m) * rcp_2(d);
}

namespace pg8 {
constexpr int BM = 256, BK = 64, HALF = 128, HTB = HALF * BK * 2, STAGE_BYTES = 8 * HTB, NXCD = 8, WGM = 8;
__device__ __forceinline__ int lds_byte(int r, int c) { const int st = (r >> 4) * 2 + (c >> 5), rr = r & 15, cc = c & 31, ob = rr * 64 + cc * 2; return st * 1024 + (ob ^ (((ob >> 9) & 1) << 5)); }
__device__ __forceinline__ void stage_rc(int b, int& R, int& C) { const int st = b / 1024, sb = b % 1024, swz = sb ^ (((sb >> 9) & 1) << 5); R = (st >> 1) * 16 + swz / 64; C = (st & 1) * 32 + (swz % 64) / 2; }
__device__ __forceinline__ int perm32(int rho) { const int n = rho >> 4, i = rho & 15; return 8 * (i >> 2) + 4 * n + (i & 3); }

struct Unit { int pm, pn; };
struct Gemm { const bf16_t* A; const bf16_t* Bt; int lda, ldb, K, dilA, dilB; };
__device__ __forceinline__ const char* panel_base(const bf16_t* base, int p, int ld, int dil, int K) {
    if (dil == 0) return (const char*)base + (size_t)p * 256 * (size_t)ld * 2;
    const int b = p >> 4, pp = p & 15, per = 16 / dil, r = pp / per, q0 = (pp % per) * 256;
    const size_t tok = (size_t)b * SEQ + (size_t)q0 * dil + r;
    return (const char*)base + tok * (size_t)K * 2;
}

struct StaticOrder {
    int nM, nN, nwg, G, c;
    __device__ void init(int M, int N, int G_, int c_) { nM = M / BM; nN = N / BM; nwg = nM * nN; G = G_; c = c_; }
    __device__ bool next(int i, Unit& u) const {
        const long L = (long)i * G + c; if (L >= nwg) return false;
        int wgid = (int)L; { const int q = nwg / NXCD, r = nwg % NXCD, xcd = wgid % NXCD, off = wgid / NXCD; wgid = (xcd < r ? xcd * (q + 1) : r * (q + 1) + (xcd - r) * q) + off; }
        const int nig = WGM * nN, gid = wgid / nig, fm = gid * WGM, gsz = (nM - fm) < WGM ? (nM - fm) : WGM;
        u.pm = fm + ((wgid % nig) % gsz); u.pn = (wgid % nig) / gsz; return true;
    }
};

template <class Epi>
__device__ __forceinline__ void gemm_phase(int wv, LAS unsigned char* lds, const Gemm g, const StaticOrder& S, const Epi& E) {
    const int tid = opaque_tid(wv), wid = __builtin_amdgcn_readfirstlane(tid >> 6), lane = tid & 63, wr = wid >> 2, wc = wid & 3, fr = lane & 15, fq = lane >> 4;
    const int K = g.K, nt = K / BK;
    unsigned voffA[2], voffB[2];
#pragma unroll
    for (int i = 0; i < 2; ++i) { int R, C; stage_rc(tid * 16 + i * 8192, R, C); const int Rb = Epi::PERM ? ((R & ~31) + perm32(R & 31)) : R;
        voffA[i] = (unsigned)(R * g.lda + C) * 2u; voffB[i] = (unsigned)(Rb * g.ldb + C) * 2u; }
    const size_t kstep = (size_t)(BK * 2);
    const size_t hstepA = (size_t)HALF * g.lda * 2, hstepB = (size_t)HALF * g.ldb * 2;
    const unsigned ldsw = (unsigned)wid * 1024u;
    const int aoff = lds_byte(wr * 64 + fr, fq * 8), boff = lds_byte(wc * 32 + fr, fq * 8);
#define PG8_SA(b, h) (((b) * 2 + (h)) * HTB)
#define PG8_SB(b, h) ((4 + (b) * 2 + (h)) * HTB)
#define PG8_STAGE(bufoff, gbase, voff) do { _Pragma("unroll") for (int _i = 0; _i < 2; ++_i) \
        __builtin_amdgcn_global_load_lds((const unsigned*)((const char*)(gbase) + (voff)[_i]), (LAS unsigned*)(lds + (bufoff) + ldsw + _i * 8192), 16, 0, 0); } while (0)
#define PG8_LDA(dst, b, h) do { _Pragma("unroll") for (int m = 0; m < 4; ++m) _Pragma("unroll") for (int k = 0; k < 2; ++k) dst[m][k] = *(const LAS bf16x8*)(lds + PG8_SA(b, h) + aoff + m * 2048 + k * 1024); } while (0)
#define PG8_LDB(dst, b, h) do { _Pragma("unroll") for (int n = 0; n < 2; ++n) _Pragma("unroll") for (int k = 0; k < 2; ++k) dst[n][k] = *(const LAS bf16x8*)(lds + PG8_SB(b, h) + boff + n * 2048 + k * 1024); } while (0)
#define PG8_MMA(ai, bj, At, Bt) do { __builtin_amdgcn_s_setprio(1); _Pragma("unroll") for (int m = 0; m < 4; ++m) _Pragma("unroll") for (int n = 0; n < 2; ++n) _Pragma("unroll") for (int k = 0; k < 2; ++k) \
        acc[ai][bj][m][n] = __builtin_amdgcn_mfma_f32_16x16x32_bf16(Bt[n][k], At[m][k], acc[ai][bj][m][n], 0, 0, 0); __builtin_amdgcn_s_setprio(0); } while (0)
#define PG8_WAIT_V(n) asm volatile("s_waitcnt vmcnt(" #n ")" ::: "memory")
#define PG8_WAIT_L(n) asm volatile("s_waitcnt lgkmcnt(" #n ")" ::: "memory")
#define PG8_BAR __builtin_amdgcn_s_barrier()
#define PG8_SCHED __builtin_amdgcn_sched_barrier(0)
    Unit cur, nxt; int ui = 0;
    if (!S.next(0, cur)) return;
    f32x4 acc[2][2][4][2];
#pragma unroll
    for (int a = 0; a < 2; ++a)
#pragma unroll
        for (int b = 0; b < 2; ++b)
#pragma unroll
            for (int m = 0; m < 4; ++m)
#pragma unroll
                for (int n = 0; n < 2; ++n) acc[a][b][m][n] = (f32x4){0.f, 0.f, 0.f, 0.f};
    bf16x8 At[4][2], B0[2][2], B1[2][2];
    const char* cA = panel_base(g.A, cur.pm, g.lda, g.dilA, K); const char* cB = panel_base(g.Bt, cur.pn, g.ldb, g.dilB, K);
    PG8_STAGE(PG8_SB(0, 0), cB, voffB); PG8_STAGE(PG8_SA(0, 0), cA, voffA); PG8_STAGE(PG8_SB(0, 1), cB + hstepB, voffB); PG8_STAGE(PG8_SA(0, 1), cA + hstepA, voffA);
    if (wr == 1) PG8_BAR;
    PG8_WAIT_V(4); PG8_BAR;
    PG8_STAGE(PG8_SB(1, 0), cB + kstep, voffB); PG8_STAGE(PG8_SA(1, 0), cA + kstep, voffA); PG8_STAGE(PG8_SB(1, 1), cB + hstepB + kstep, voffB);
    PG8_WAIT_V(6); PG8_BAR;
    for (;;) {
        const bool has_next = S.next(ui + 1, nxt);
        const char* nA = has_next ? panel_base(g.A, nxt.pm, g.lda, g.dilA, K) : cA; const char* nB = has_next ? panel_base(g.Bt, nxt.pn, g.ldb, g.dilB, K) : cB;
        for (int t = 0; t < nt; t += 2) {
            const bool last = (t == nt - 2);
            const char* a1 = cA + (size_t)(t + 1) * kstep;
            const char* a2 = last ? nA : cA + (size_t)(t + 2) * kstep; const char* b2 = last ? nB : cB + (size_t)(t + 2) * kstep;
            const char* a3 = a2 + kstep; const char* b3 = b2 + kstep;
            PG8_LDB(B0, 0, 0); PG8_SCHED; PG8_LDA(At, 0, 0); PG8_STAGE(PG8_SA(1, 1), a1 + hstepA, voffA);
            PG8_WAIT_L(8); PG8_BAR; PG8_WAIT_L(0); PG8_MMA(0, 0, At, B0); PG8_BAR; PG8_SCHED;
            PG8_LDB(B1, 0, 1); PG8_STAGE(PG8_SB(0, 0), b2, voffB);
            PG8_BAR; PG8_WAIT_L(0); PG8_MMA(0, 1, At, B1); PG8_BAR;
            PG8_LDA(At, 0, 1); PG8_STAGE(PG8_SA(0, 0), a2, voffA);
            PG8_BAR; PG8_WAIT_L(0); PG8_MMA(1, 0, At, B0); PG8_BAR; PG8_SCHED;
            PG8_STAGE(PG8_SB(0, 1), b2 + hstepB, voffB);
            PG8_WAIT_V(6); PG8_BAR; PG8_MMA(1, 1, At, B1); PG8_BAR;
            PG8_LDB(B0, 1, 0); PG8_SCHED; PG8_LDA(At, 1, 0); PG8_STAGE(PG8_SA(0, 1), a2 + hstepA, voffA);
            PG8_WAIT_L(8); PG8_BAR; PG8_WAIT_L(0); PG8_MMA(0, 0, At, B0); PG8_BAR; PG8_SCHED;
            PG8_LDB(B1, 1, 1); PG8_STAGE(PG8_SB(1, 0), b3, voffB);
            PG8_BAR; PG8_WAIT_L(0); PG8_MMA(0, 1, At, B1); PG8_BAR;
            PG8_LDA(At, 1, 1); PG8_STAGE(PG8_SA(1, 0), a3, voffA);
            PG8_BAR; PG8_WAIT_L(0); PG8_MMA(1, 0, At, B0); PG8_BAR; PG8_SCHED;
            PG8_STAGE(PG8_SB(1, 1), b3 + hstepB, voffB);
            PG8_WAIT_V(6); PG8_BAR; PG8_MMA(1, 1, At, B1); PG8_BAR;
        }
        E(acc, cur, wr, wc, fr, fq);
        if (!has_next) break;
#pragma unroll
        for (int a = 0; a < 2; ++a)
#pragma unroll
            for (int b = 0; b < 2; ++b)
#pragma unroll
                for (int m = 0; m < 4; ++m)
#pragma unroll
                    for (int n = 0; n < 2; ++n) acc[a][b][m][n] = (f32x4){0.f, 0.f, 0.f, 0.f};
        cur = nxt; cA = nA; cB = nB; ++ui;
    }
    PG8_WAIT_V(0);
    if (wr == 0) PG8_BAR;
    PG8_BAR;
#undef PG8_SA
#undef PG8_SB
#undef PG8_STAGE
#undef PG8_LDA
#undef PG8_LDB
#undef PG8_MMA
#undef PG8_WAIT_V
#undef PG8_WAIT_L
#undef PG8_BAR
#undef PG8_SCHED
}
}

struct EpiBf16 {
    static constexpr bool PERM = true;
    __device__ __forceinline__ void touch(const pg8::Unit&, LAS unsigned*, int) const {}
    bf16_t* O; bf16_t* O2; size_t ldc; int ACT;
    __device__ __forceinline__ void operator()(const f32x4 (&acc)[2][2][4][2], const pg8::Unit& u, int wr, int wc, int fr, int fq) const {
        const int row0 = u.pm * 256 + wr * 64 + fr, col0 = u.pn * 256 + wc * 32 + 8 * fq;
        if (ACT == 6) {
            const int pn = u.pn;
            if (pn < 12) { const int gq = pn >> 2, sh = 2 * gq; bf16_t* Og = O + (size_t)gq * T * 1024;
#pragma unroll
                for (int ai = 0; ai < 2; ++ai)
#pragma unroll
                    for (int m = 0; m < 4; ++m) { const int r = row0 + ai * 128 + m * 16, b = r >> 12, sq = r & 4095, pos = ((sq & ((1 << sh) - 1)) << (12 - sh)) + (sq >> sh);
                        bf16_t* rowp = Og + ((size_t)(b * 8 + (pn & 3) * 2) * 4096 + pos) * 128 + wc * 32 + 8 * fq;
#pragma unroll
                        for (int bj = 0; bj < 2; ++bj) { const f32x4 v0 = acc[ai][bj][m][0], v1 = acc[ai][bj][m][1];
                            u32x4 w; w.x = cvt_pk_bf16(v0[0], v0[1]); w.y = cvt_pk_bf16(v0[2], v0[3]); w.z = cvt_pk_bf16(v1[0], v1[1]); w.w = cvt_pk_bf16(v1[2], v1[3]);
                            *(u32x4*)(rowp + (size_t)bj * 4096 * 128) = w; } }
            } else { bf16_t* Oz = O2 + (pn - 12) * 256 + wc * 32 + 8 * fq;
#pragma unroll
                for (int ai = 0; ai < 2; ++ai)
#pragma unroll
                    for (int m = 0; m < 4; ++m) { bf16_t* rowp = Oz + (size_t)(row0 + ai * 128 + m * 16) * 1024;
#pragma unroll
                        for (int bj = 0; bj < 2; ++bj) { f32x4 v0 = acc[ai][bj][m][0], v1 = acc[ai][bj][m][1];
#pragma unroll
                            for (int j = 0; j < 4; ++j) { v0[j] = silu_f(v0[j]); v1[j] = silu_f(v1[j]); }
                            u32x4 w; w.x = cvt_pk_bf16(v0[0], v0[1]); w.y = cvt_pk_bf16(v0[2], v0[3]); w.z = cvt_pk_bf16(v1[0], v1[1]); w.w = cvt_pk_bf16(v1[2], v1[3]);
                            *(u32x4*)(rowp + bj * 128) = w; } }
            }
            return;
        }
        const bool vt = (ACT == 3), kh = (ACT == 4), qh = (ACT == 5);
        const size_t bjs = vt ? (size_t)16384 : (kh || qh) ? (size_t)4096 * 128 : (size_t)128;
#pragma unroll
        for (int ai = 0; ai < 2; ++ai)
#pragma unroll
            for (int m = 0; m < 4; ++m) { bf16_t* rowp = vt ? O + ((size_t)(((u.pn >> 4) * 2 + ai) * 32 + (u.pn & 15) * 2) * 128 + (wr * 64 + m * 16 + fr)) * 128 + wc * 32 + 8 * fq
                                                      : kh ? O + ((size_t)((u.pm >> 4) * 2) * 4096 + ((row0 + ai * 128 + m * 16) & 4095)) * 128 + wc * 32 + 8 * fq
                                                      : qh ? O + ((size_t)((u.pm >> 4) * 8 + u.pn * 2) * 4096 + ((row0 + ai * 128 + m * 16) & 4095)) * 128 + wc * 32 + 8 * fq
                                                           : O + (size_t)(row0 + ai * 128 + m * 16) * ldc + col0;
#pragma unroll
                for (int bj = 0; bj < 2; ++bj) { f32x4 v0 = acc[ai][bj][m][0], v1 = acc[ai][bj][m][1];
                    if (ACT == 2) {
#pragma unroll
                        for (int j = 0; j < 4; ++j) { v0[j] = silu_f(v0[j]); v1[j] = silu_f(v1[j]); } }
                    u32x4 w; w.x = cvt_pk_bf16(v0[0], v0[1]); w.y = cvt_pk_bf16(v0[2], v0[3]); w.z = cvt_pk_bf16(v1[0], v1[1]); w.w = cvt_pk_bf16(v1[2], v1[3]);
                    *(u32x4*)(rowp + bj * bjs) = w; } }
    }
};
struct EpiVg {
    static constexpr bool PERM = true;
    __device__ __forceinline__ void touch(const pg8::Unit&, LAS unsigned*, int) const {}
    bf16_t* O; float* part;
    __device__ __forceinline__ void operator()(const f32x4 (&acc)[2][2][4][2], const pg8::Unit& u, int wr, int wc, int fr, int fq) const {
        const int row0 = u.pm * 256 + wr * 64 + fr, col0 = u.pn * 256 + wc * 32 + 8 * fq;
        float cs[2][2][4];
#pragma unroll
        for (int bj = 0; bj < 2; ++bj)
#pragma unroll
            for (int n = 0; n < 2; ++n)
#pragma unroll
                for (int j = 0; j < 4; ++j) cs[bj][n][j] = 0.f;
#pragma unroll
        for (int ai = 0; ai < 2; ++ai)
#pragma unroll
            for (int m = 0; m < 4; ++m) { bf16_t* rowp = O + ((size_t)(u.pn * 2) * 8 + u.pm) * 32768 + (wr * 64 + fr + ai * 128 + m * 16) * 128 + wc * 32 + 8 * fq;
#pragma unroll
                for (int bj = 0; bj < 2; ++bj) { f32x4 v0 = acc[ai][bj][m][0], v1 = acc[ai][bj][m][1];
#pragma unroll
                    for (int j = 0; j < 4; j += 2) { const f32x2 a = gelu_2((f32x2){v0[j], v0[j + 1]}), b = gelu_2((f32x2){v1[j], v1[j + 1]});
                        v0[j] = a.x; v0[j + 1] = a.y; v1[j] = b.x; v1[j + 1] = b.y;
                        cs[bj][0][j] += a.x * a.x; cs[bj][0][j + 1] += a.y * a.y; cs[bj][1][j] += b.x * b.x; cs[bj][1][j + 1] += b.y * b.y; }
                    u32x4 w; w.x = cvt_pk_bf16(v0[0], v0[1]); w.y = cvt_pk_bf16(v0[2], v0[3]); w.z = cvt_pk_bf16(v1[0], v1[1]); w.w = cvt_pk_bf16(v1[2], v1[3]);
                    *(u32x4*)(rowp + (size_t)bj * 8 * 32768) = w; } }
#pragma unroll
        for (int bj = 0; bj < 2; ++bj)
#pragma unroll
            for (int n = 0; n < 2; ++n)
#pragma unroll
                for (int j = 0; j < 4; ++j) { float s = cs[bj][n][j]; s += dpp_f(s, 0xB1); s += dpp_f(s, 0x4E); s += dpp_f(s, 0x141); s += dpp_f(s, 0x140);
                    if (fr == 0) part[(size_t)(col0 + bj * 128 + 4 * n + j) * 16 + u.pm * 2 + wr] = s; }
    }
};
struct EpiUZ {
    static constexpr bool PERM = true;
    const bf16_t* mixed; bf16_t* Y;
    __device__ __forceinline__ void touch(const pg8::Unit& u, LAS unsigned* dummy, int tid) const {
        __builtin_amdgcn_global_load_lds((const unsigned*)((const char*)(mixed + (size_t)(u.pm * 256) * 2048 + u.pn * 128) + (unsigned)((tid >> 1) * 4096 + (tid & 1) * 128)), dummy, 4, 0, 0); }
    __device__ __forceinline__ void operator()(const f32x4 (&acc)[2][2][4][2], const pg8::Unit& u, int wr, int wc, int fr, int fq) const {
        const int row0 = u.pm * 256 + wr * 64 + fr, col0 = u.pn * 128 + wc * 32 + 8 * fq;
        u32x4 mxa[2][4];
#pragma unroll
        for (int ai = 0; ai < 2; ++ai)
#pragma unroll
            for (int m = 0; m < 4; ++m) mxa[ai][m] = *(const u32x4*)(mixed + (size_t)(row0 + ai * 128 + m * 16) * 2048 + col0);
#pragma unroll
        for (int ai = 0; ai < 2; ++ai)
#pragma unroll
            for (int m = 0; m < 4; ++m) { const size_t off = (size_t)(row0 + ai * 128 + m * 16) * 2048 + col0;
                const u32x4 mx = mxa[ai][m];
                const f32x4 u0 = acc[ai][0][m][0], u1 = acc[ai][0][m][1], z0 = acc[ai][1][m][0], z1 = acc[ai][1][m][1];
                const f32x2 y01 = gate_2((f32x2){u0[0], u0[1]}, (f32x2){z0[0], z0[1]}, (f32x2){bf_lo(mx.x), bf_hi(mx.x)});
                const f32x2 y23 = gate_2((f32x2){u0[2], u0[3]}, (f32x2){z0[2], z0[3]}, (f32x2){bf_lo(mx.y), bf_hi(mx.y)});
                const f32x2 y45 = gate_2((f32x2){u1[0], u1[1]}, (f32x2){z1[0], z1[1]}, (f32x2){bf_lo(mx.z), bf_hi(mx.z)});
                const f32x2 y67 = gate_2((f32x2){u1[2], u1[3]}, (f32x2){z1[2], z1[3]}, (f32x2){bf_lo(mx.w), bf_hi(mx.w)});
                const float y[8] = {y01.x, y01.y, y23.x, y23.y, y45.x, y45.y, y67.x, y67.y};
                u32x4 w; w.x = cvt_pk_bf16(y[0], y[1]); w.y = cvt_pk_bf16(y[2], y[3]); w.z = cvt_pk_bf16(y[4], y[5]); w.w = cvt_pk_bf16(y[6], y[7]);
                *(u32x4*)(Y + off) = w; }
    }
};
struct EpiOut {
    static constexpr bool PERM = false;
    const float* base; float* out; const float* gate;
    __device__ __forceinline__ void touch(const pg8::Unit& u, LAS unsigned* dummy, int tid) const {
        const char* b0 = (const char*)(base + (size_t)(u.pm * 256) * 1024 + u.pn * 256);
#pragma unroll
        for (int i = 0; i < 4; ++i) { const int line = tid + i * 512; __builtin_amdgcn_global_load_lds((const unsigned*)(b0 + (unsigned)((line >> 3) * 4096 + (line & 7) * 128)), dummy, 4, 0, 0); } }
    __device__ __forceinline__ void operator()(const f32x4 (&acc)[2][2][4][2], const pg8::Unit& u, int wr, int wc, int fr, int fq) const {
        const int row0 = u.pm * 256 + wr * 64 + fr, col0 = u.pn * 256 + wc * 32 + 4 * fq, b = u.pm >> 4;
        f32x4 gv[2][2];
#pragma unroll
        for (int bj = 0; bj < 2; ++bj)
#pragma unroll
            for (int n = 0; n < 2; ++n) gv[bj][n] = *(const f32x4*)(gate + (size_t)b * MODW + col0 + bj * 128 + n * 16);
#pragma unroll
        for (int ai = 0; ai < 2; ++ai) {
            f32x4 bs[4][2][2];
#pragma unroll
            for (int m = 0; m < 4; ++m) { const size_t off = (size_t)(row0 + ai * 128 + m * 16) * 1024 + col0;
#pragma unroll
                for (int bj = 0; bj < 2; ++bj)
#pragma unroll
                    for (int n = 0; n < 2; ++n) bs[m][bj][n] = *(const f32x4*)(base + off + bj * 128 + n * 16); }
#pragma unroll
            for (int m = 0; m < 4; ++m) { const size_t off = (size_t)(row0 + ai * 128 + m * 16) * 1024 + col0;
#pragma unroll
                for (int bj = 0; bj < 2; ++bj)
#pragma unroll
                    for (int n = 0; n < 2; ++n) *(f32x4*)(out + off + bj * 128 + n * 16) = bs[m][bj][n] + gv[bj][n] * acc[ai][bj][m][n]; }
        }
    }
};

__device__ void ada_unit(int wv, const Params& p, LAS float* lf, int unit) {
    const int tid = opaque_tid(wv);
    int set, cu;
    if (unit < 48) { set = 0; cu = unit; } else if (unit < 96) { set = 1; cu = unit - 48; } else if (unit < 128) { set = 2; cu = unit - 96; }
    else if (unit < 176) { set = 3; cu = unit - 128; } else { set = 4; cu = unit - 176; }
    const float* W; const float* bias; int ncol, modoff;
    if (set < 2) { W = p.in[2] + (size_t)set * 1024 * 3072; bias = p.in[3] + set * 3072; ncol = 3072; modoff = set * 3072; }
    else if (set == 2) { W = p.in[10]; bias = p.in[11]; ncol = 2048; modoff = 6144; }
    else { W = p.in[15] + (size_t)(set - 3) * 1024 * 3072; bias = p.in[16] + (set - 3) * 3072; ncol = 3072; modoff = 8192 + (set - 3) * 3072; }
    const float* c = p.in[1];
    for (int i = tid; i < 8192; i += 512) lf[i] = silu_f(c[i]);
    __syncthreads();
    const int w = tid >> 6, lane = tid & 63, col = cu * 64 + lane;
    float a0 = 0.f, a1 = 0.f, a2 = 0.f, a3 = 0.f, a4 = 0.f, a5 = 0.f, a6 = 0.f, a7 = 0.f;
#pragma unroll 16
    for (int k = w * 128; k < w * 128 + 128; ++k) {
        const float wv = W[(size_t)k * ncol + col];
        a0 += lf[k] * wv; a1 += lf[1024 + k] * wv; a2 += lf[2048 + k] * wv; a3 += lf[3072 + k] * wv;
        a4 += lf[4096 + k] * wv; a5 += lf[5120 + k] * wv; a6 += lf[6144 + k] * wv; a7 += lf[7168 + k] * wv;
    }
    LAS float* red = lf + 8192;
    red[(w * 8 + 0) * 64 + lane] = a0; red[(w * 8 + 1) * 64 + lane] = a1; red[(w * 8 + 2) * 64 + lane] = a2; red[(w * 8 + 3) * 64 + lane] = a3;
    red[(w * 8 + 4) * 64 + lane] = a4; red[(w * 8 + 5) * 64 + lane] = a5; red[(w * 8 + 6) * 64 + lane] = a6; red[(w * 8 + 7) * 64 + lane] = a7;
    __syncthreads();
    { const int b = w; float s = 0.f;
#pragma unroll
      for (int w2 = 0; w2 < 8; ++w2) s += red[(w2 * 8 + b) * 64 + lane];
      float* mod = (float*)(p.ws + WS_MOD);
      mod[(size_t)b * MODW + modoff + col] = s + bias[col]; }
    __syncthreads();
}

struct CT { const float* src; bf16_t* dst; int K, Nsrc, srccol0, row0, k0; };
__device__ __forceinline__ CT conv_decode(const Params& p, int tile) {
    int j = 0, tt = tile; CT c; c.K = 1024; int coloff = 0, map = 0;
    if (tt < 1024) { j = tt >> 9; tt &= 511; c.src = p.in[5] + (size_t)j * 1024 * 6144; c.dst = (bf16_t*)(p.ws + WS_WVA) + (size_t)j * 2048 * 1024; c.Nsrc = 6144; coloff = 2048; }
    else if (tt < 3072) { tt -= 1024; j = tt >> 10; tt &= 1023; c.src = p.in[5] + (size_t)j * 1024 * 6144; c.dst = (bf16_t*)(p.ws + WS_WUZ) + (size_t)j * 4096 * 1024; c.Nsrc = 6144; map = 1; }
    else if (tt < 4096) { tt -= 3072; j = tt >> 9; tt &= 511; c.src = p.in[9] + (size_t)j * 2048 * 1024; c.dst = (bf16_t*)(p.ws + WS_WOA) + (size_t)j * 1024 * 2048; c.Nsrc = 1024; c.K = 2048; }
    else if (tt < 4480) { tt -= 4096; c.src = p.in[13]; c.dst = (bf16_t*)(p.ws + WS_WKV); c.Nsrc = 1536; }
    else if (tt < 6528) { tt -= 4480; j = tt >> 10; tt &= 1023; c.src = p.in[18] + (size_t)j * 1024 * 4096; c.dst = (bf16_t*)(p.ws + WS_WQB) + (size_t)j * 4096 * 1024; c.Nsrc = 4096; }
    else { tt -= 6528; j = tt >> 8; tt &= 255; c.src = p.in[20] + (size_t)j * 1024 * 1024; c.dst = (bf16_t*)(p.ws + WS_WOB) + (size_t)j * 1024 * 1024; c.Nsrc = 1024; }
    const int kt = c.K / 64, rt = tt / kt, kc = tt % kt; c.row0 = rt * 64; c.k0 = kc * 64;
    c.srccol0 = c.row0 + coloff;
    if (map == 1) { const int pn = c.row0 >> 8, bj = (c.row0 >> 7) & 1, jj = c.row0 & 127; c.srccol0 = (bj ? 4096 : 0) + pn * 128 + jj; }
    return c;
}
__device__ __forceinline__ void conv_load(const CT& c, int tid, f32x4 (&v)[2]) {
    const int kk = tid >> 4, n4 = (tid & 15) * 4;
#pragma unroll
    for (int h = 0; h < 2; ++h) v[h] = *(const f32x4*)(c.src + (size_t)(c.k0 + kk + h * 32) * c.Nsrc + c.srccol0 + n4);
}
__device__ __forceinline__ void conv_store(LAS float* tl, const CT& c, int tid, const f32x4 (&v)[2]) {
    { const int kk = tid >> 4, n4 = (tid & 15) * 4;
#pragma unroll
      for (int h = 0; h < 2; ++h) { const int k = kk + h * 32; tl[(n4 + 0) * 65 + k] = v[h][0]; tl[(n4 + 1) * 65 + k] = v[h][1]; tl[(n4 + 2) * 65 + k] = v[h][2]; tl[(n4 + 3) * 65 + k] = v[h][3]; } }
    __syncthreads();
    { const int n = tid >> 3, k8 = (tid & 7) * 8; const LAS float* r = tl + n * 65 + k8;
      u32x4 w; w.x = cvt_pk_bf16(r[0], r[1]); w.y = cvt_pk_bf16(r[2], r[3]); w.z = cvt_pk_bf16(r[4], r[5]); w.w = cvt_pk_bf16(r[6], r[7]);
      *(u32x4*)(c.dst + (size_t)(c.row0 + n) * c.K + c.k0 + k8) = w; }
    __syncthreads();
}

__device__ void phase0(int wv, const Params& p, LAS unsigned char* lds) {
    LAS float* lf = (LAS float*)lds;
    const int bx = opaque_bid(), tid = opaque_tid(wv);
    f32x4 vcur[2], vnxt[2];
    CT cur = conv_decode(p, bx);
    conv_load(cur, tid, vcur);
    if (bx < 224) ada_unit(wv, p, lf, bx);
    for (int tile = bx; tile < 7040; tile += gridDim.x) {
        const int nt = tile + gridDim.x; CT nxt = cur;
        if (nt < 7040) { nxt = conv_decode(p, nt); conv_load(nxt, tid, vnxt); }
        conv_store(lf, cur, tid, vcur);
        cur = nxt; vcur[0] = vnxt[0]; vcur[1] = vnxt[1];
    }
}

__device__ void norm_phase(int wv, const float* x, const float* g, const float* mod  , bf16_t* dst, const float* g2 = nullptr, const float* mod2 = nullptr, bf16_t* dst2 = nullptr) {
    const int tid0 = opaque_tid(wv), w = tid0 >> 6, lane = tid0 & 63;
    for (int row = (opaque_bid() * 8 + w) * 4; row < T; row += gridDim.x * 32) {
        const int b = row >> 12; const float* xr = x + (size_t)row * 1024;
        f32x4 v[4][4]; float ss[4];
#pragma unroll
        for (int r = 0; r < 4; ++r)
#pragma unroll
            for (int j = 0; j < 4; ++j) v[r][j] = *(const f32x4*)(xr + r * 1024 + lane * 4 + j * 256);
#pragma unroll
        for (int r = 0; r < 4; ++r) { float q = 0.f;
#pragma unroll
            for (int j = 0; j < 4; ++j) q += v[r][j][0] * v[r][j][0] + v[r][j][1] * v[r][j][1] + v[r][j][2] * v[r][j][2] + v[r][j][3] * v[r][j][3];
            q += dpp_f(q, 0xB1); q += dpp_f(q, 0x4E); q += dpp_f(q, 0x141); q += dpp_f(q, 0x140); q += shx(q, 16, lane); q += shx(q, 32, lane);
            ss[r] = rsqrtf(q * (1.0f / 1024.0f) + EPS); }
        const float* mb = mod + (size_t)b * MODW;
#pragma unroll
        for (int j = 0; j < 4; ++j) { const int col = lane * 4 + j * 256;
            const f32x4 gg = *(const f32x4*)(g + col), sh = *(const f32x4*)(mb + col), sc = *(const f32x4*)(mb + 1024 + col);
            const f32x4 gs = gg * (sc + 1.0f);
#pragma unroll
            for (int r = 0; r < 4; ++r) { const f32x4 h = v[r][j] * ss[r] * gs + sh;
                u32x2 wv; wv.x = cvt_pk_bf16(h[0], h[1]); wv.y = cvt_pk_bf16(h[2], h[3]);
                *(u32x2*)(dst + (size_t)(row + r) * 1024 + col) = wv; }
            if (dst2) { const float* mb2 = mod2 + (size_t)b * MODW;
                const f32x4 gg2 = *(const f32x4*)(g2 + col), sh2 = *(const f32x4*)(mb2 + col), sc2 = *(const f32x4*)(mb2 + 1024 + col);
                const f32x4 gs2 = gg2 * (sc2 + 1.0f);
#pragma unroll
                for (int r = 0; r < 4; ++r) { const f32x4 h = v[r][j] * ss[r] * gs2 + sh2;
                    u32x2 wv; wv.x = cvt_pk_bf16(h[0], h[1]); wv.y = cvt_pk_bf16(h[2], h[3]);
                    *(u32x2*)(dst2 + (size_t)(row + r) * 1024 + col) = wv; } } }
    }
}

__device__ void mix_phase(int wv, const Params& p, LAS unsigned char* lds, int l) {
    const int tid = opaque_tid(wv), w = __builtin_amdgcn_readfirstlane(tid >> 6), lane = tid & 63, fr = lane & 15, fq = lane >> 4;
    const bf16_t* VgT = (const bf16_t*)(p.ws + WS_BUF1); bf16_t* mixed = (bf16_t*)(p.ws + WS_BUF2);
    const float* part = (const float*)(p.ws + WS_PART);
    const float* Wsp = p.in[7] + (size_t)l * 8 * 128 * 128; const float* bsp = p.in[8] + (size_t)l * 8 * 128; const float* sgu = p.in[6] + (size_t)l * 2048;
    LAS float* rs = (LAS float*)(lds + 32768);
    bf16x8 afN[2][4]; f32x4 wsN[4][2]; f32x4 ptN[4];
#define MIX_LOAD(U) do { const int g_ = (U) & 7, c_ = (U) >> 3; \
        _Pragma("unroll") for (int mt = 0; mt < 2; ++mt) _Pragma("unroll") for (int ks = 0; ks < 4; ++ks) \
            afN[mt][ks] = *(const bf16x8*)(VgT + ((size_t)c_ * 8 + g_) * 32768 + (w * 32 + (fr >> 2) * 8 + mt * 4 + (fr & 3)) * 128 + ks * 32 + fq * 8); \
        _Pragma("unroll") for (int it = 0; it < 4; ++it) { const int idx = it * 512 + tid, t = idx >> 4, cs = idx & 15; const float* wp = Wsp + ((size_t)g_ * 128 + t) * 128 + cs * 8; \
            wsN[it][0] = *(const f32x4*)wp; wsN[it][1] = *(const f32x4*)(wp + 4); } \
        if (tid < 128) { const float* pp = part + (size_t)(c_ * 128 + tid) * 16; _Pragma("unroll") for (int i = 0; i < 4; ++i) ptN[i] = *(const f32x4*)(pp + i * 4); } } while (0)
    int u = opaque_bid();
    if (u < 2048) MIX_LOAD(u);
    for (; u < 2048; u += gridDim.x) {
        const int g = u & 7, c = u >> 3;
        bf16x8 af[2][4]; f32x4 ws[4][2];
#pragma unroll
        for (int mt = 0; mt < 2; ++mt)
#pragma unroll
            for (int ks = 0; ks < 4; ++ks) af[mt][ks] = afN[mt][ks];
#pragma unroll
        for (int it = 0; it < 4; ++it) { ws[it][0] = wsN[it][0]; ws[it][1] = wsN[it][1]; }
        __syncthreads();
        if (tid < 128) { float s = 0.f;
#pragma unroll
            for (int i = 0; i < 4; ++i) { const f32x4 q = ptN[i]; s += q[0] + q[1] + q[2] + q[3]; }
            rs[tid] = rsqrtf(s * (1.0f / 2048.0f) + EPS); }
        __syncthreads();
#pragma unroll
        for (int it = 0; it < 4; ++it) { const int idx = it * 512 + tid, t = idx >> 4, cs = idx & 15, s0 = cs * 8;
            const f32x4 w0 = ws[it][0], w1 = ws[it][1];
            float v[8];
#pragma unroll
            for (int e = 0; e < 4; ++e) { v[e] = (s0 + e <= t) ? w0[e] * rs[s0 + e] : 0.f; v[4 + e] = (s0 + 4 + e <= t) ? w1[e] * rs[s0 + 4 + e] : 0.f; }
            u32x4 pk; pk.x = cvt_pk_bf16(v[0], v[1]); pk.y = cvt_pk_bf16(v[2], v[3]); pk.z = cvt_pk_bf16(v[4], v[5]); pk.w = cvt_pk_bf16(v[6], v[7]);
            *(LAS u32x4*)(lds + t * 256 + ((cs ^ (t & 15)) << 4)) = pk; }
        float bbv[8]; f32x4 sg0, sg1;
#pragma unroll
        for (int nt = 0; nt < 8; ++nt) bbv[nt] = bsp[g * 128 + nt * 16 + fr];
        { const int e0 = g * 256 + w * 32 + fq * 8; sg0 = *(const f32x4*)(sgu + e0); sg1 = *(const f32x4*)(sgu + e0 + 4); }
        if (u + (int)gridDim.x < 2048) MIX_LOAD(u + (int)gridDim.x);
        __syncthreads();
#pragma unroll
        for (int nt = 0; nt < 8; ++nt) {
            f32x4 acc0 = {0.f, 0.f, 0.f, 0.f}, acc1 = {0.f, 0.f, 0.f, 0.f};
#pragma unroll
            for (int ks = 0; ks < 4; ++ks) {
                if (ks * 32 <= nt * 16 + 15) {
                    const bf16x8 bfr = *(const LAS bf16x8*)(lds + (nt * 16 + fr) * 256 + (((ks * 4 + fq) ^ fr) << 4));
                    acc0 = __builtin_amdgcn_mfma_f32_16x16x32_bf16(af[0][ks], bfr, acc0, 0, 0, 0);
                    acc1 = __builtin_amdgcn_mfma_f32_16x16x32_bf16(af[1][ks], bfr, acc1, 0, 0, 0);
                }
            }
            const int tl = nt * 16 + fr; const size_t token = (size_t)c * 128 + tl; const float bb = bbv[nt];
            { const int e0 = g * 256 + w * 32 + fq * 8;
              u32x4 wv; wv.x = cvt_pk_bf16(acc0[0] * sg0[0] + bb, acc0[1] * sg0[1] + bb); wv.y = cvt_pk_bf16(acc0[2] * sg0[2] + bb, acc0[3] * sg0[3] + bb);
              wv.z = cvt_pk_bf16(acc1[0] * sg1[0] + bb, acc1[1] * sg1[1] + bb); wv.w = cvt_pk_bf16(acc1[2] * sg1[2] + bb, acc1[3] * sg1[3] + bb);
              *(u32x4*)(mixed + token * 2048 + e0) = wv; }
        }
    }
#undef MIX_LOAD
}

constexpr int VPITCH = 528;
template <int mode> __device__ void attn_phase(int wv, const Params& p, LAS unsigned char* lds, int l) {
    const int tid = opaque_tid(wv), w = __builtin_amdgcn_readfirstlane(tid >> 6), lane = tid & 63, fr = lane & 15, fq = lane >> 4;
    LAS unsigned char* Ks = lds; LAS unsigned char* Vs = lds + 65536;
    const float* qg = p.in[19] + (size_t)l * 128; const float* kg = p.in[14];
    float* LSE = (float*)(p.ws + WS_LSE);
    for (int u = (mode ? 1024 : 0) + opaque_bid(); u < (mode ? 1536 : 1024); u += gridDim.x) {
        const int k = u & 1; int t = u >> 1; const int blk = ((t & 31) + 5 * (u / (int)gridDim.x)) & 31; t >>= 5; const int b = t & 7, g = t >> 3;
        const int dsh = 2 * g, nbk = 32 >> dsh, n = blk & (nbk - 1);
        bf16_t* QO = (bf16_t*)(p.ws + WS_QO) + (size_t)g * T * 1024;
        const bf16_t* Kd = (const bf16_t*)(p.ws + WS_KD) + (size_t)g * T * 256;
        const bf16_t* Vt = (const bf16_t*)(p.ws + WS_VT) + (size_t)g * 256 * T;
        const size_t row0 = (size_t)b * SEQ + blk * 128;
        int tl = tid; asm volatile("" : "+v"(tl));
        const int lfr = tl & 15, lfq = (tl >> 4) & 3;
        const int j = k * 4 + (w >> 1);
        const char* qbase = (const char*)(QO + ((size_t)(b * 8 + j) * 4096 + blk * 128 + (w & 1) * 64) * 128);
        const unsigned qoff = (unsigned)(lfr * 256 + lfq * 16);
        u32x4 raw[2][4];
#pragma unroll
        for (int qt = 0; qt < 2; ++qt)
#pragma unroll
            for (int ks = 0; ks < 4; ++ks) raw[qt][ks] = *(const u32x4*)(qbase + (qoff + qt * 4096 + ks * 64));
        __syncthreads();
        {
            const char* kbase = (const char*)(Kd + ((size_t)(b * 2 + k) * 4096 + blk * 128 - 128) * 128);
            const char* vbase = (const char*)(Vt + ((size_t)((b * 2 + k) * 32 + blk - 1) * 128) * 128);
            u32x4 kraw[8], vraw[8];
#pragma unroll
            for (int it = 0; it < 8; ++it) { const int idx = it * 512 + tl; int row = idx >> 4; const int c = idx & 15; if (n == 0 && it < 4) row += 128;
                kraw[it] = *(const u32x4*)(kbase + (unsigned)(row * 256 + c * 16)); }
#pragma unroll
            for (int it = 0; it < 8; ++it) { const int idx = it * 512 + tl, h = idx >> 5; int c = idx & 31; if (n == 0 && c < 16) c += 16;
                vraw[it] = *(const u32x4*)(vbase + (unsigned)((c >> 4) * 32768 + h * 256 + (c & 15) * 16)); }
#pragma unroll
            for (int it = 0; it < 8; ++it) { const int idx = it * 512 + tl, row = idx >> 4, c = idx & 15; const u32x4 raw = kraw[it];
                float v[8]; v[0] = bf_lo(raw.x); v[1] = bf_hi(raw.x); v[2] = bf_lo(raw.y); v[3] = bf_hi(raw.y); v[4] = bf_lo(raw.z); v[5] = bf_hi(raw.z); v[6] = bf_lo(raw.w); v[7] = bf_hi(raw.w);
                float ss = 0.f;
#pragma unroll
                for (int e = 0; e < 8; ++e) ss += v[e] * v[e];
                ss += dpp_f(ss, 0xB1); ss += dpp_f(ss, 0x4E); ss += dpp_f(ss, 0x141); ss += dpp_f(ss, 0x140);
                const float rstd = rsqrtf(ss * (1.0f / 128.0f) + EPS);
                u32x4 pk; pk.x = cvt_pk_bf16(v[0] * rstd, v[1] * rstd); pk.y = cvt_pk_bf16(v[2] * rstd, v[3] * rstd); pk.z = cvt_pk_bf16(v[4] * rstd, v[5] * rstd); pk.w = cvt_pk_bf16(v[6] * rstd, v[7] * rstd);
                *(LAS u32x4*)(Ks + row * 256 + ((c ^ (row & 15)) << 4)) = pk; }
#pragma unroll
            for (int it = 0; it < 8; ++it) { const int idx = it * 512 + tl, h = idx >> 5, c = idx & 31;
                *(LAS u32x4*)(Vs + h * VPITCH + c * 16) = vraw[it]; }
        }
        __syncthreads();
        const float slope = exp2f(-8.0f * (float)(g * 8 + j + 1) / 24.0f);
        const float nsl = -slope * (float)(1 << dsh) * LOG2E;
#pragma unroll 1
        for (int sub = 0; sub < 2; ++sub) {
            const int i0 = (w & 1) * 64 + sub * 32;
            bf16x8 qf[2][4]; float mq[2];
            {
                if (sub == 1) {
#pragma unroll
                    for (int qt = 0; qt < 2; ++qt)
#pragma unroll
                        for (int ks = 0; ks < 4; ++ks) raw[qt][ks] = *(const u32x4*)(qbase + (qoff + 8192 + qt * 4096 + ks * 64));
                }
                float rq[2];
#pragma unroll
                for (int qt = 0; qt < 2; ++qt) { float ss = 0.f;
#pragma unroll
                    for (int ks = 0; ks < 4; ++ks) { const u32x4 r = raw[qt][ks];
                        ss += bf_lo(r.x) * bf_lo(r.x) + bf_hi(r.x) * bf_hi(r.x) + bf_lo(r.y) * bf_lo(r.y) + bf_hi(r.y) * bf_hi(r.y) + bf_lo(r.z) * bf_lo(r.z) + bf_hi(r.z) * bf_hi(r.z) + bf_lo(r.w) * bf_lo(r.w) + bf_hi(r.w) * bf_hi(r.w); }
                    ss += shx(ss, 16, lane); ss += shx(ss, 32, lane);
                    rq[qt] = rsqrtf(ss * (1.0f / 128.0f) + EPS) * (0.08838834764831845f * LOG2E); }
                float q2[2] = {0.f, 0.f};
#pragma unroll
                for (int ks = 0; ks < 4; ++ks) { const int h0 = ks * 32 + fq * 8;
                    const f32x4 qa = *(const f32x4*)(qg + h0), qb = *(const f32x4*)(qg + h0 + 4), ka = *(const f32x4*)(kg + h0), kb = *(const f32x4*)(kg + h0 + 4);
                    const f32x4 ga = qa * ka, gb = qb * kb;
#pragma unroll
                    for (int qt = 0; qt < 2; ++qt) { const u32x4 r = raw[qt][ks]; const float sc = rq[qt];
                        float v[8]; v[0] = bf_lo(r.x) * sc * ga[0]; v[1] = bf_hi(r.x) * sc * ga[1]; v[2] = bf_lo(r.y) * sc * ga[2]; v[3] = bf_hi(r.y) * sc * ga[3];
                        v[4] = bf_lo(r.z) * sc * gb[0]; v[5] = bf_hi(r.z) * sc * gb[1]; v[6] = bf_lo(r.w) * sc * gb[2]; v[7] = bf_hi(r.w) * sc * gb[3];
#pragma unroll
                        for (int e = 0; e < 8; ++e) q2[qt] += v[e] * v[e];
                        u32x4 pk; pk.x = cvt_pk_bf16(v[0], v[1]); pk.y = cvt_pk_bf16(v[2], v[3]); pk.z = cvt_pk_bf16(v[4], v[5]); pk.w = cvt_pk_bf16(v[6], v[7]);
                        qf[qt][ks] = __builtin_bit_cast(bf16x8, pk); } }
#pragma unroll
                for (int qt = 0; qt < 2; ++qt) { float t2 = q2[qt]; t2 += shx(t2, 16, lane); t2 += shx(t2, 32, lane); mq[qt] = sqrtf(t2) * (11.313708499f * 1.01f) + 0.05f; }
            }
            float lrun[2] = {0.f, 0.f};
            f32x4 oacc[8][2];
#pragma unroll
            for (int ht = 0; ht < 8; ++ht) { oacc[ht][0] = (f32x4){0.f, 0.f, 0.f, 0.f}; oacc[ht][1] = (f32x4){0.f, 0.f, 0.f, 0.f}; }
            const int kc0 = i0 >> 5; int kc_lo = kc0; const int kc_hi = kc0 + 5; if (n == 0 && kc_lo < 4) kc_lo = 4;
            bf16x8 kfr[2][4];
#define LOADK(KC) do { _Pragma("unroll") for (int kt = 0; kt < 2; ++kt) _Pragma("unroll") for (int ks = 0; ks < 4; ++ks) \
                kfr[kt][ks] = *(const LAS bf16x8*)(Ks + ((KC) * 32 + kt * 16 + fr) * 256 + (((ks * 4 + fq) ^ fr) << 4)); } while (0)
#pragma unroll 1
            for (int kc = kc_lo; kc < kc_hi; ++kc) {
                LOADK(kc);
                u32x2 vlo[8], vhi[8];
#pragma unroll
                for (int ht = 0; ht < 4; ++ht) { const LAS unsigned char* vp = Vs + ((ht >> 1) * 32 + (fr >> 2) * 8 + (ht & 1) * 4 + (fr & 3)) * VPITCH + (kc * 32 + fq * 4) * 2;
                    vlo[ht] = *(const LAS u32x2*)vp; vhi[ht] = *(const LAS u32x2*)(vp + 32); }
                __builtin_amdgcn_sched_barrier(0);
                f32x4 sacc[2][2];
#pragma unroll
                for (int qt = 0; qt < 2; ++qt) { const float c0 = nsl * (float)(128 + i0 + qt * 16 + fr - kc * 32 - fq * 4) - mq[qt];
#pragma unroll
                    for (int kt = 0; kt < 2; ++kt)
#pragma unroll
                        for (int e = 0; e < 4; ++e) sacc[kt][qt][e] = c0 - nsl * (float)(kt * 16 + e); }
#pragma unroll
                for (int ks = 0; ks < 4; ++ks)
#pragma unroll
                    for (int kt = 0; kt < 2; ++kt) {
                        sacc[kt][0] = __builtin_amdgcn_mfma_f32_16x16x32_bf16(kfr[kt][ks], qf[0][ks], sacc[kt][0], 0, 0, 0);
                        sacc[kt][1] = __builtin_amdgcn_mfma_f32_16x16x32_bf16(kfr[kt][ks], qf[1][ks], sacc[kt][1], 0, 0, 0); }
                __builtin_amdgcn_sched_barrier(0);
#pragma unroll
                for (int ht = 4; ht < 8; ++ht) { const LAS unsigned char* vp = Vs + ((ht >> 1) * 32 + (fr >> 2) * 8 + (ht & 1) * 4 + (fr & 3)) * VPITCH + (kc * 32 + fq * 4) * 2;
                    vlo[ht] = *(const LAS u32x2*)vp; vhi[ht] = *(const LAS u32x2*)(vp + 32); }
                __builtin_amdgcn_sched_barrier(0);
                const bool edge = (kc == kc0) || (kc == kc0 + 4);
                bf16x8 pf[2];
#pragma unroll
                for (int qt = 0; qt < 2; ++qt) {
                    float ps = 0.f;
                    if (edge) {
                        const int iq = i0 + qt * 16 + fr;
#pragma unroll
                        for (int kt = 0; kt < 2; ++kt)
#pragma unroll
                            for (int e = 0; e < 4; ++e) { const int jk = kc * 32 + kt * 16 + fq * 4 + e, dq = 128 + iq - jk;
                                const float pv = (dq >= 0 && dq <= 128) ? ex2(sacc[kt][qt][e]) : 0.f; sacc[kt][qt][e] = pv; ps += pv; }
                    } else {
#pragma unroll
                        for (int kt = 0; kt < 2; ++kt)
#pragma unroll
                            for (int e = 0; e < 4; ++e) { const float pv = ex2(sacc[kt][qt][e]); sacc[kt][qt][e] = pv; ps += pv; }
                    }
                    lrun[qt] += ps;
                    u32x4 pk; pk.x = cvt_pk_bf16(sacc[0][qt][0], sacc[0][qt][1]); pk.y = cvt_pk_bf16(sacc[0][qt][2], sacc[0][qt][3]);
                    pk.z = cvt_pk_bf16(sacc[1][qt][0], sacc[1][qt][1]); pk.w = cvt_pk_bf16(sacc[1][qt][2], sacc[1][qt][3]);
                    pf[qt] = __builtin_bit_cast(bf16x8, pk);
                }
#pragma unroll
                for (int ht = 0; ht < 8; ++ht) {
                    u32x4 vv; vv.x = vlo[ht].x; vv.y = vlo[ht].y; vv.z = vhi[ht].x; vv.w = vhi[ht].y;
                    const bf16x8 vf = __builtin_bit_cast(bf16x8, vv);
                    oacc[ht][0] = __builtin_amdgcn_mfma_f32_16x16x32_bf16(vf, pf[0], oacc[ht][0], 0, 0, 0);
                    oacc[ht][1] = __builtin_amdgcn_mfma_f32_16x16x32_bf16(vf, pf[1], oacc[ht][1], 0, 0, 0); }
            }
#undef LOADK
#pragma unroll
            for (int qt = 0; qt < 2; ++qt) {
                float lt = lrun[qt]; lt += shx(lt, 16, lane); lt += shx(lt, 32, lane);
                const float inv = 1.0f / lt; const size_t row = row0 + i0 + qt * 16 + fr;
                char* obase = (char*)qbase + (unsigned)(lfr * 256 + lfq * 16 + sub * 8192 + qt * 4096);
                const float lse_here = (mq[qt] + log2f(lt)) * LN2;
                if (mode == 0) {
#pragma unroll
                    for (int pp = 0; pp < 4; ++pp) { const f32x4 o0 = oacc[2 * pp][qt] * inv, o1 = oacc[2 * pp + 1][qt] * inv;
                        u32x4 wv; wv.x = cvt_pk_bf16(o0[0], o0[1]); wv.y = cvt_pk_bf16(o0[2], o0[3]); wv.z = cvt_pk_bf16(o1[0], o1[1]); wv.w = cvt_pk_bf16(o1[2], o1[3]);
                        *(u32x4*)(obase + pp * 64) = wv; }
                    if (fq == 0) LSE[((size_t)g * T + row) * 8 + j] = lse_here;
                } else {
                    const int pos = (int)(row - (size_t)b * SEQ), sq = (pos & 255) * 16 + (pos >> 8), p1 = (sq & 3) * 1024 + (sq >> 2);
                    const bf16_t* o0b = (const bf16_t*)(p.ws + WS_QO) + (size_t)(b * 8 + j) * 4096 * 128; const bf16_t* o1b = o0b + (size_t)T * 1024;
                    const bf16_t* zb = (const bf16_t*)(p.ws + WS_ZS) + (size_t)b * SEQ * 1024 + j * 128; bf16_t* yb = (bf16_t*)(p.ws + WS_HB) + (size_t)b * SEQ * 1024 + j * 128;
                    const unsigned oa = (unsigned)(sq * 128 + lfq * 8), ob = (unsigned)(p1 * 128 + lfq * 8), oz = (unsigned)(sq * 1024 + lfq * 8);
                    const float l0 = LSE[((size_t)b * SEQ + sq) * 8 + j], l1 = LSE[((size_t)T + (size_t)b * SEQ + p1) * 8 + j];
                    const float mx = fmaxf(l0, fmaxf(l1, lse_here));
                    float e0 = ex2((l0 - mx) * LOG2E), e1 = ex2((l1 - mx) * LOG2E), e2 = ex2((lse_here - mx) * LOG2E);
                    const float ei = 1.0f / (e0 + e1 + e2); e0 *= ei; e1 *= ei; e2 *= ei * inv;
                    {
                        u32x4 a0[4], a1[4], zz[4];
#pragma unroll
                        for (int pp = 0; pp < 4; ++pp) { a0[pp] = *(const u32x4*)(o0b + (oa + pp * 32)); a1[pp] = *(const u32x4*)(o1b + (ob + pp * 32)); zz[pp] = *(const u32x4*)(zb + (oz + pp * 32)); }
#pragma unroll
                        for (int pp = 0; pp < 4; ++pp) { const f32x4 o0 = oacc[2 * pp][qt], o1 = oacc[2 * pp + 1][qt]; u32x4 y;
#define MRG2(c, va, vb) cvt_pk_bf16((e0 * bf_lo(a0[pp].c) + e1 * bf_lo(a1[pp].c) + e2 * (va)) * bf_lo(zz[pp].c), (e0 * bf_hi(a0[pp].c) + e1 * bf_hi(a1[pp].c) + e2 * (vb)) * bf_hi(zz[pp].c))
                            y.x = MRG2(x, o0[0], o0[1]); y.y = MRG2(y, o0[2], o0[3]); y.z = MRG2(z, o1[0], o1[1]); y.w = MRG2(w, o1[2], o1[3]);
#undef MRG2
                            *(u32x4*)(yb + (oz + pp * 32)) = y; }
                    }
                }
            }
        }
    }
}

__device__ void merge_phase(int wv, const Params& p) {
    const int tid0 = opaque_tid(wv), w = tid0 >> 6, lane = tid0 & 63;
    const bf16_t* QO = (const bf16_t*)(p.ws + WS_QO); const float* LSE = (const float*)(p.ws + WS_LSE);
    const bf16_t* Zs = (const bf16_t*)(p.ws + WS_ZS); bf16_t* Y = (bf16_t*)(p.ws + WS_HB);
    for (int t = opaque_bid() * 8 + w; t < T; t += gridDim.x * 8) {
        const int b = t >> 12, s = t & 4095;
        const size_t r0 = (size_t)t, r1 = (size_t)b * SEQ + (s & 3) * 1024 + (s >> 2), r2 = (size_t)b * SEQ + (s & 15) * 256 + (s >> 4);
        float l0[2], l1[2], l2[2]; u32x4 o0[2], o1[2], o2[2], z[2];
#pragma unroll
        for (int i = 0; i < 2; ++i) {
            const int col = lane * 8 + i * 512, head = col >> 7;
            l0[i] = LSE[(r0) * 8 + head]; l1[i] = LSE[((size_t)T + r1) * 8 + head]; l2[i] = LSE[((size_t)2 * T + r2) * 8 + head];
            { const size_t hb = (size_t)(b * 8 + head) * 4096; const int hh = col & 127;
              o0[i] = *(const u32x4*)(QO + (hb + (r0 & 4095)) * 128 + hh); o1[i] = *(const u32x4*)(QO + (size_t)T * 1024 + (hb + (r1 & 4095)) * 128 + hh); o2[i] = *(const u32x4*)(QO + (size_t)2 * T * 1024 + (hb + (r2 & 4095)) * 128 + hh); }
            z[i] = *(const u32x4*)(Zs + (size_t)t * 1024 + col);
        }
#pragma unroll
        for (int i = 0; i < 2; ++i) {
            const int col = lane * 8 + i * 512;
            const float mx = fmaxf(l0[i], fmaxf(l1[i], l2[i]));
            float e0 = ex2((l0[i] - mx) * LOG2E), e1 = ex2((l1[i] - mx) * LOG2E), e2 = ex2((l2[i] - mx) * LOG2E);
            const float inv = 1.0f / (e0 + e1 + e2); e0 *= inv; e1 *= inv; e2 *= inv;
            u32x4 y;
#define MRG(c) cvt_pk_bf16((e0 * bf_lo(o0[i].c) + e1 * bf_lo(o1[i].c) + e2 * bf_lo(o2[i].c)) * bf_lo(z[i].c), (e0 * bf_hi(o0[i].c) + e1 * bf_hi(o1[i].c) + e2 * bf_hi(o2[i].c)) * bf_hi(z[i].c))
            y.x = MRG(x); y.y = MRG(y); y.z = MRG(z); y.w = MRG(w);
#undef MRG
            *(u32x4*)(Y + (size_t)t * 1024 + col) = y;
        }
    }
}

#define XB_TMO      128
#define XB_XCNT(j)  (256  + 64 * (j))
#define XB_XSUB(j)  (1280 + 64 * (j))
#define XB_XGEN(j)  (2304 + 64 * (j))
#define XB_TOP      3328
#define XB_TOPGEN   3392
#define XCD_BAR_WORDS 3456
#define XB_SPIN_CAP (1u << 22)
__device__ __forceinline__ unsigned xb_ld(unsigned* p)              { return __hip_atomic_load(p, __ATOMIC_RELAXED, __HIP_MEMORY_SCOPE_AGENT); }
__device__ __forceinline__ unsigned xb_add(unsigned* p, unsigned v) { return __hip_atomic_fetch_add(p, v, __ATOMIC_RELAXED, __HIP_MEMORY_SCOPE_AGENT); }
__device__ __forceinline__ unsigned xb_xcc_id() { return (unsigned)__builtin_amdgcn_s_getreg((3 << 11) | 20) & 0xFu; }
#define XB_SPIN(cond, bar) do { unsigned _sp = 0; while (cond) { __builtin_amdgcn_s_sleep(1); \
    if ((++_sp & 255u) == 0u) { if (xb_ld(&(bar)[XB_TMO])) break; if (_sp > XB_SPIN_CAP) { atomicAdd(&(bar)[XB_TMO], 1u); break; } } } } while (0)
struct XcdBarrier { unsigned* bar; unsigned x; volatile LAS unsigned* st; };
__device__ __forceinline__ XcdBarrier xcd_barrier_post(unsigned* bar, volatile LAS unsigned* st) {
    XcdBarrier b; b.bar = bar; b.x = xb_xcc_id(); b.st = st;
    if (threadIdx.x == 0) (void)xb_add(&bar[XB_XCNT(b.x)], 1u);
    return b;
}
__device__ __forceinline__ void xcd_barrier_complete(unsigned* bar, unsigned x, unsigned& nloc, unsigned& nx) {
    const unsigned G = gridDim.x * gridDim.y * gridDim.z;
    unsigned sum, cnt, mine, sp = 0u;
    for (;;) {
        sum = 0u; cnt = 0u; mine = 0u;
#pragma unroll
        for (unsigned j = 0; j < 16; ++j) { const unsigned c = xb_ld(&bar[XB_XCNT(j)]); sum += c; cnt += (c > 0u) ? 1u : 0u; mine = (j == x) ? c : mine; }
        if (sum == G) break;
        __builtin_amdgcn_s_sleep(1);
        if ((++sp & 255u) == 0u) { if (xb_ld(&bar[XB_TMO])) break; if (sp > XB_SPIN_CAP) { atomicAdd(&bar[XB_TMO], 1u); break; } }
    }
    nloc = mine > 0u ? mine : 1u; nx = cnt > 0u ? cnt : 1u;
}
__device__ __forceinline__ void xcd_barrier(const XcdBarrier& b, bool leader) {
    asm volatile("s_waitcnt vmcnt(0)" ::: "memory");
    __syncthreads();
    if (leader) {
        unsigned* bar = b.bar;
        __builtin_amdgcn_s_waitcnt(0);
        unsigned nloc = b.st[0], nx = b.st[1];
        if (nloc == 0u) { xcd_barrier_complete(bar, b.x, nloc, nx); b.st[0] = nloc; b.st[1] = nx; }
        const unsigned old = xb_add(&bar[XB_XSUB(b.x)], 1u);
        const unsigned gen = old / nloc;
        if (old + 1u == (gen + 1u) * nloc) {
            __builtin_amdgcn_fence(__ATOMIC_RELEASE, "agent");
            asm volatile("s_waitcnt vmcnt(0)" ::: "memory");
            const unsigned og = xb_add(&bar[XB_TOP], 1u);
            const unsigned tg = og / nx;
            if (og + 1u == (tg + 1u) * nx) xb_add(&bar[XB_TOPGEN], 1u);
            else XB_SPIN(xb_ld(&bar[XB_TOPGEN]) == tg, bar);
            __builtin_amdgcn_fence(__ATOMIC_ACQUIRE, "agent");
            xb_add(&bar[XB_XGEN(b.x)], 1u);
            asm volatile("s_waitcnt vmcnt(0)" ::: "memory");
        } else {
            XB_SPIN(xb_ld(&bar[XB_XGEN(b.x)]) == gen, bar);
            __builtin_amdgcn_fence(__ATOMIC_ACQUIRE, "agent");
            asm volatile("s_waitcnt vmcnt(0)" ::: "memory");
        }
    }
    __syncthreads();
}

constexpr int NPH = 22;
__global__ void __launch_bounds__(512, 2) yoco_fwd(Params p) {
    extern __shared__ __attribute__((aligned(16))) unsigned char shm[];
    LAS unsigned char* lds = (LAS unsigned char*)shm;
    cg::grid_group grid = cg::this_grid();
    if (p.never) grid.sync();
    volatile LAS unsigned* xst = (volatile LAS unsigned*)(lds + LDS_BYTES - 16);
    if (threadIdx.x < 4) xst[threadIdx.x] = 0u;
    __syncthreads();
    const XcdBarrier xbar = xcd_barrier_post((unsigned*)p.ws, xst);
    const int wv = __builtin_amdgcn_readfirstlane((int)(threadIdx.x >> 6));
#define GSYNC() xcd_barrier(xbar, opaque_tid(wv) == 0)
    const int G = gridDim.x;
#pragma unroll 1
    for (int ph = 0; ph < NPH; ++ph) {
        const int bid = opaque_bid();
        unsigned char* ws = p.ws;
        const float* MOD = (const float*)(ws + WS_MOD);
        int kind, l;
        if (ph == 0) { kind = 0; l = 0; }
        else if (ph <= 10) { l = (ph - 1) / 5; kind = 1 + (ph - 1) % 5; }
        else if (ph == 11) { kind = 6; l = 0; }
        else if (ph == 12) { kind = 7; l = 0; }
        else if (ph == 17) { kind = 11; l = 1; }
        else { l = ph >= 18 ? 1 : 0; const int q = (ph - (l ? 18 : 13)); kind = q == 0 ? 8 : q == 1 ? 9 : q == 2 ? 10 : 5; }
        const bool layerB = ph > 10;
        const int kind0 = kind; const int nrep = ((PH_REP >> kind0) & 1) ? (kind0 == 9 ? 3 : 2) : 1;
#pragma unroll 1
        for (int rep = 0; rep < nrep; ++rep) {
        kind = (kind0 == 9 && rep == 1) ? 8 : kind0; if (rep > 0 && kind0 == 9) GSYNC();
        if (kind == 0) { if (PH_MASK & 1) phase0(wv, p, lds); }
        else if (kind == 1) { if (PH_MASK & 2) norm_phase(wv, l == 0 ? p.in[0] : p.out, p.in[4] + l * 1024, MOD + l * 3072, (bf16_t*)(ws + WS_H)); }
        else if (kind == 2) { if (PH_MASK & 4) {
            pg8::Gemm g{(const bf16_t*)(ws + WS_WVA) + (size_t)l * 2048 * 1024, (const bf16_t*)(ws + WS_H), 1024, 1024, 1024, 0, 0}; pg8::StaticOrder S; S.init(2048, T, G, bid);
            EpiVg E{(bf16_t*)(ws + WS_BUF1), (float*)(ws + WS_PART)}; pg8::gemm_phase<EpiVg>(wv, lds, g, S, E); } }
        else if (kind == 3) { if (PH_MASK & 8) mix_phase(wv, p, lds, l); }
        else if (kind == 4) { if (PH_MASK & 16) {
            pg8::Gemm g{(const bf16_t*)(ws + WS_H), (const bf16_t*)(ws + WS_WUZ) + (size_t)l * 4096 * 1024, 1024, 1024, 1024, 0, 0}; pg8::StaticOrder S; S.init(T, 4096, G, bid);
            EpiUZ E{(const bf16_t*)(ws + WS_BUF2), (bf16_t*)(ws + WS_BUF1)}; pg8::gemm_phase<EpiUZ>(wv, lds, g, S, E); } }
        else if (kind == 5) { if (PH_MASK & 32) {
            pg8::Gemm g; g.dilA = 0; g.dilB = 0; const float* base; const float* gate;
            if (!layerB) { g.A = (const bf16_t*)(ws + WS_BUF1); g.Bt = (const bf16_t*)(ws + WS_WOA) + (size_t)l * 1024 * 2048; g.lda = 2048; g.ldb = 2048; g.K = 2048; base = (l == 0) ? p.in[0] : p.out; gate = MOD + l * 3072 + 2048; }
            else { g.A = (const bf16_t*)(ws + WS_HB); g.Bt = (const bf16_t*)(ws + WS_WOB) + (size_t)l * 1024 * 1024; g.lda = 1024; g.ldb = 1024; g.K = 1024; base = p.out; gate = MOD + 8192 + l * 3072 + 2048; }
            pg8::StaticOrder S; S.init(T, 1024, G, bid);
            EpiOut E{base, p.out, gate}; pg8::gemm_phase<EpiOut>(wv, lds, g, S, E); } }
        else if (kind == 6) { if (PH_MASK & 2) { norm_phase(wv, p.out, p.in[12], MOD + 6144, (bf16_t*)(ws + WS_ZS), p.in[17], MOD + 8192, (bf16_t*)(ws + WS_HB)); } }
        else if (kind == 11) { if (PH_MASK & 2) norm_phase(wv, p.out, p.in[17] + 1024, MOD + 8192 + 3072, (bf16_t*)(ws + WS_HB)); }
        else if (kind == 7 || kind == 8) { if (PH_MASK & 64) {
            const int ncall = kind == 7 ? 6 : 1;
#pragma unroll 1
            for (int ci = 0; ci < ncall; ++ci) {
                pg8::Gemm g; g.K = 1024; pg8::StaticOrder S; EpiBf16 E; E.ACT = 0; E.O2 = nullptr;
                if (kind == 7) {
                    const int gq = ci % 3, d = 1 << (2 * gq); const bf16_t* HKV = (const bf16_t*)(ws + WS_ZS); const bf16_t* WKV = (const bf16_t*)(ws + WS_WKV);
                    if (ci < 3) { g.A = HKV; g.Bt = WKV + (size_t)gq * 256 * 1024; g.lda = d * 1024; g.ldb = 1024; g.dilA = d; g.dilB = 0; S.init(T, 256, G, (bid + (ci & 1) * 128) % G);
                        E.O = (bf16_t*)(ws + WS_KD) + (size_t)gq * T * 256; E.ldc = 256; E.ACT = 4; }
                    else { g.A = WKV + (size_t)(768 + gq * 256) * 1024; g.Bt = HKV; g.lda = 1024; g.ldb = d * 1024; g.dilA = 0; g.dilB = d; S.init(256, T, G, (bid + (ci & 1) * 128) % G);
                        E.O = (bf16_t*)(ws + WS_VT) + (size_t)gq * 256 * T; E.ldc = (size_t)T; E.ACT = 3; }
                } else {
                    g.A = (const bf16_t*)(ws + WS_HB); g.Bt = (const bf16_t*)(ws + WS_WQB) + (size_t)l * 4096 * 1024; g.lda = 1024; g.ldb = 1024; g.dilA = 0; g.dilB = 0; E.ldc = 1024;
                    E.O = (bf16_t*)(ws + WS_QO); E.O2 = (bf16_t*)(ws + WS_ZS); E.ACT = 6;
                    S.init(T, 4096, G, bid);
                }
                pg8::gemm_phase<EpiBf16>(wv, lds, g, S, E);
            } } }
        else if (kind == 9) { if (PH_MASK & 256) attn_phase<0>(wv, p, lds, l); }
        else if (kind == 10) { if (PH_MASK & 256) attn_phase<1>(wv, p, lds, l); }
        }
        if (ph + 1 < NPH) GSYNC();
    }
}

extern "C" void kernel_launch(void* const* d_in, const int* in_sizes, int n_in, void* d_out, int out_size, void* d_ws, size_t ws_size, hipStream_t stream) {
    static int grid = 0;
    if (grid == 0) {
        if (n_in != 21 || ws_size < WS_END) { fprintf(stderr, "kernel_launch: unexpected n_in %d / ws_size %zu (need %zu)\n", n_in, ws_size, (size_t)WS_END); grid = -1; return; }
        int dev = 0, cus = 0, per_cu = 0;
        hipGetDevice(&dev); hipDeviceGetAttribute(&cus, hipDeviceAttributeMultiprocessorCount, dev);
        if (hipFuncSetAttribute((const void*)yoco_fwd, hipFuncAttributeMaxDynamicSharedMemorySize, LDS_BYTES) != hipSuccess) { fprintf(stderr, "kernel_launch: hipFuncSetAttribute failed\n"); grid = -1; return; }
        hipOccupancyMaxActiveBlocksPerMultiprocessor(&per_cu, (const void*)yoco_fwd, 512, LDS_BYTES);
        if (per_cu < 1) { fprintf(stderr, "kernel_launch: occupancy query says %d blocks per CU\n", per_cu); per_cu = 1; }
        (void)hipGetLastError();
        grid = cus;
    }
    if (grid < 0) return;
    Params p{};
    for (int i = 0; i < 21; ++i) p.in[i] = (const float*)d_in[i];
    p.out = (float*)d_out; p.ws = (unsigned char*)d_ws; p.never = 0; p.pad = 0;
    if (hipMemsetAsync(d_ws, 0, XCD_BAR_WORDS * 4, stream) != hipSuccess) { fprintf(stderr, "kernel_launch: memset failed\n"); return; }
    void* args[] = {&p};
    hipError_t e = hipLaunchCooperativeKernel((const void*)yoco_fwd, dim3(grid), dim3(512), args, LDS_BYTES, stream);
    if (e != hipSuccess) fprintf(stderr, "cooperative launch failed: %s (grid %d)\n", hipGetErrorString(e), grid);
}
```

```cpp
#include <hip/hip_runtime.h>
#include <hip/hip_cooperative_groups.h>
#include <cstdio>
namespace cg = cooperative_groups;

#define LAS __attribute__((address_space(3)))
typedef unsigned short bf16_t;
typedef short bf16x8 __attribute__((ext_vector_type(8)));
typedef float f32x4 __attribute__((ext_vector_type(4)));
typedef unsigned u32x4 __attribute__((ext_vector_type(4)));
typedef unsigned u32x2 __attribute__((ext_vector_type(2)));

constexpr int T = 32768, DM = 1024, SEQ = 4096;
constexpr int MODW = 14336;
constexpr float EPS = 1e-6f;
constexpr float LOG2E = 1.4426950408889634f;
constexpr float LN2 = 0.6931471805599453f;

constexpr size_t MiB = 1024 * 1024;
constexpr size_t WS_MOD  = 64 * 1024;
constexpr size_t WS_PART = 1 * MiB;
constexpr size_t WS_LSE  = 3 * MiB;
constexpr size_t WS_WVA  = 6 * MiB;
constexpr size_t WS_WUZ  = WS_WVA + 8 * MiB;
constexpr size_t WS_WOA  = WS_WUZ + 16 * MiB;
constexpr size_t WS_WKV  = WS_WOA + 8 * MiB;
constexpr size_t WS_WQB  = WS_WKV + 3 * MiB;
constexpr size_t WS_WOB  = WS_WQB + 16 * MiB;
constexpr size_t WS_BIG  = WS_WOB + 4 * MiB;
constexpr size_t WS_H    = WS_BIG;
constexpr size_t WS_BUF1 = WS_H + 64 * MiB;
constexpr size_t WS_BUF2 = WS_BUF1 + 128 * MiB;
constexpr size_t WS_QO   = WS_BIG;
constexpr size_t WS_KD   = WS_QO + 192 * MiB;
constexpr size_t WS_VT   = WS_KD + 48 * MiB;
constexpr size_t WS_ZS   = WS_VT + 48 * MiB;
constexpr size_t WS_HB   = WS_ZS + 64 * MiB;
constexpr size_t WS_END  = WS_HB + 64 * MiB;
constexpr int LDS_BYTES = 137216;

#ifndef PH_REP
#define PH_REP 0
#endif
#ifndef PH_MASK
#define PH_MASK 0xFFFF
#endif
struct Params { const float* in[21]; float* out; unsigned char* ws; int never; int pad; };

__device__ __forceinline__ unsigned cvt_pk_bf16(float lo, float hi) { unsigned r; asm volatile("v_cvt_pk_bf16_f32 %0, %1, %2" : "=v"(r) : "v"(lo), "v"(hi)); return r; }
__device__ __forceinline__ float bf_lo(unsigned w) { return __uint_as_float(w << 16); }
__device__ __forceinline__ float bf_hi(unsigned w) { return __uint_as_float(w & 0xffff0000u); }
__device__ __forceinline__ int opaque_tid(int wv) { int t; asm volatile("v_mbcnt_lo_u32_b32 %0, -1, 0\n\tv_mbcnt_hi_u32_b32 %0, -1, %0" : "=v"(t)); return (wv << 6) | t; }
__device__ __forceinline__ int opaque_bid() { int t = blockIdx.x; asm volatile("" : "+s"(t)); return t; }
#define dpp_f(x, ctrl) __builtin_bit_cast(float, __builtin_amdgcn_update_dpp(0, __builtin_bit_cast(int, (x)), (ctrl), 0xF, 0xF, true))
__device__ __forceinline__ float shx(float v, int mask, int lane) { return __builtin_bit_cast(float, __builtin_amdgcn_ds_bpermute((lane ^ mask) << 2, __builtin_bit_cast(int, v))); }
__device__ __forceinline__ float ex2(float x) { return __builtin_amdgcn_exp2f(x); }
__device__ __forceinline__ float silu_f(float x) { return x * __builtin_amdgcn_rcpf(1.0f + ex2(-LOG2E * x)); }
__device__ __forceinline__ float gelu_f(float x) {
    const float y = 0.7978845608028654f * (x + 0.044715f * x * x * x);
    return x * __builtin_amdgcn_rcpf(1.0f + ex2(-2.0f * LOG2E * y));
}

typedef float f32x2 __attribute__((ext_vector_type(2)));
constexpr float GC1 = -2.0f * 1.4426950408889634f * 0.7978845608028654f, GC3 = GC1 * 0.044715f;
__device__ __forceinline__ f32x2 gelu_arg2(f32x2 x) { return x * ((x * x) * GC3 + GC1); }
__device__ __forceinline__ f32x2 ex2_2(f32x2 a) { f32x2 r; r.x = __builtin_amdgcn_exp2f(a.x); r.y = __builtin_amdgcn_exp2f(a.y); return r; }
__device__ __forceinline__ f32x2 rcp_2(f32x2 a) { f32x2 r; r.x = __builtin_amdgcn_rcpf(a.x); r.y = __builtin_amdgcn_rcpf(a.y); return r; }
__device__ __forceinline__ f32x2 gelu_2(f32x2 x) { return x * rcp_2(ex2_2(gelu_arg2(x)) + 1.0f); }
__device__ __forceinline__ f32x2 gate_2(f32x2 u, f32x2 z, f32x2 m) {
    const f32x2 d = (ex2_2(gelu_arg2(u)) + 1.0f) * (ex2_2(z * (-LOG2E)) + 1.0f);
    return ((u * z) * m) * rcp_2(d);
}

namespace pg8 {
constexpr int BM = 256, BK = 64, HALF = 128, HTB = HALF * BK * 2, STAGE_BYTES = 8 * HTB, NXCD = 8, WGM = 8;
__device__ __forceinline__ int lds_byte(int r, int c) { const int st = (r >> 4) * 2 + (c >> 5), rr = r & 15, cc = c & 31, ob = rr * 64 + cc * 2; return st * 1024 + (ob ^ (((ob >> 9) & 1) << 5)); }
__device__ __forceinline__ void stage_rc(int b, int& R, int& C) { const int st = b / 1024, sb = b % 1024, swz = sb ^ (((sb >> 9) & 1) << 5); R = (st >> 1) * 16 + swz / 64; C = (st & 1) * 32 + (swz % 64) / 2; }
__device__ __forceinline__ int perm32(int rho) { const int n = rho >> 4, i = rho & 15; return 8 * (i >> 2) + 4 * n + (i & 3); }

struct Unit { int pm, pn; };
struct Gemm { const bf16_t* A; const bf16_t* Bt; int lda, ldb, K, dilA, dilB; };
__device__ __forceinline__ const char* panel_base(const bf16_t* base, int p, int ld, int dil, int K) {
    if (dil == 0) return (const char*)base + (size_t)p * 256 * (size_t)ld * 2;
    const int b = p >> 4, pp = p & 15, per = 16 / dil, r = pp / per, q0 = (pp % per) * 256;
    const size_t tok = (size_t)b * SEQ + (size_t)q0 * dil + r;
    return (const char*)base + tok * (size_t)K * 2;
}

struct StaticOrder {
    int nM, nN, nwg, G, c;
    __device__ void init(int M, int N, int G_, int c_) { nM = M / BM; nN = N / BM; nwg = nM * nN; G = G_; c = c_; }
    __device__ bool next(int i, Unit& u) const {
        const long L = (long)i * G + c; if (L >= nwg) return false;
        int wgid = (int)L; { const int q = nwg / NXCD, r = nwg % NXCD, xcd = wgid % NXCD, off = wgid / NXCD; wgid = (xcd < r ? xcd * (q + 1) : r * (q + 1) + (xcd - r) * q) + off; }
        const int nig = WGM * nN, gid = wgid / nig, fm = gid * WGM, gsz = (nM - fm) < WGM ? (nM - fm) : WGM;
        u.pm = fm + ((wgid % nig) % gsz); u.pn = (wgid % nig) / gsz; return true;
    }
};

template <class Epi>
__device__ __forceinline__ void gemm_phase(int wv, LAS unsigned char* lds, const Gemm g, const StaticOrder& S, const Epi& E) {
    const int tid = opaque_tid(wv), wid = __builtin_amdgcn_readfirstlane(tid >> 6), lane = tid & 63, wr = wid >> 2, wc = wid & 3, fr = lane & 15, fq = lane >> 4;
    const int K = g.K, nt = K / BK;
    unsigned voffA[2], voffB[2];
#pragma unroll
    for (int i = 0; i < 2; ++i) { int R, C; stage_rc(tid * 16 + i * 8192, R, C); const int Rb = Epi::PERM ? ((R & ~31) + perm32(R & 31)) : R;
        voffA[i] = (unsigned)(R * g.lda + C) * 2u; voffB[i] = (unsigned)(Rb * g.ldb + C) * 2u; }
    const size_t kstep = (size_t)(BK * 2);
    const size_t hstepA = (size_t)HALF * g.lda * 2, hstepB = (size_t)HALF * g.ldb * 2;
    const unsigned ldsw = (unsigned)wid * 1024u;
    const int aoff = lds_byte(wr * 64 + fr, fq * 8), boff = lds_byte(wc * 32 + fr, fq * 8);
#define PG8_SA(b, h) (((b) * 2 + (h)) * HTB)
#define PG8_SB(b, h) ((4 + (b) * 2 + (h)) * HTB)
#define PG8_STAGE(bufoff, gbase, voff) do { _Pragma("unroll") for (int _i = 0; _i < 2; ++_i) \
        __builtin_amdgcn_global_load_lds((const unsigned*)((const char*)(gbase) + (voff)[_i]), (LAS unsigned*)(lds + (bufoff) + ldsw + _i * 8192), 16, 0, 0); } while (0)
#define PG8_LDA(dst, b, h) do { _Pragma("unroll") for (int m = 0; m < 4; ++m) _Pragma("unroll") for (int k = 0; k < 2; ++k) dst[m][k] = *(const LAS bf16x8*)(lds + PG8_SA(b, h) + aoff + m * 2048 + k * 1024); } while (0)
#define PG8_LDB(dst, b, h) do { _Pragma("unroll") for (int n = 0; n < 2; ++n) _Pragma("unroll") for (int k = 0; k < 2; ++k) dst[n][k] = *(const LAS bf16x8*)(lds + PG8_SB(b, h) + boff + n * 2048 + k * 1024); } while (0)
#define PG8_MMA(ai, bj, At, Bt) do { __builtin_amdgcn_s_setprio(1); _Pragma("unroll") for (int m = 0; m < 4; ++m) _Pragma("unroll") for (int n = 0; n < 2; ++n) _Pragma("unroll") for (int k = 0; k < 2; ++k) \
        acc[ai][bj][m][n] = __builtin_amdgcn_mfma_f32_16x16x32_bf16(Bt[n][k], At[m][k], acc[ai][bj][m][n], 0, 0, 0); __builtin_amdgcn_s_setprio(0); } while (0)
#define PG8_WAIT_V(n) asm volatile("s_waitcnt vmcnt(" #n ")" ::: "memory")
#define PG8_WAIT_L(n) asm volatile("s_waitcnt lgkmcnt(" #n ")" ::: "memory")
#define PG8_BAR __builtin_amdgcn_s_barrier()
#define PG8_SCHED __builtin_amdgcn_sched_barrier(0)
    Unit cur, nxt; int ui = 0;
    if (!S.next(0, cur)) return;
    f32x4 acc[2][2][4][2];
#pragma unroll
    for (int a = 0; a < 2; ++a)
#pragma unroll
        for (int b = 0; b < 2; ++b)
#pragma unroll
            for (int m = 0; m < 4; ++m)
#pragma unroll
                for (int n = 0; n < 2; ++n) acc[a][b][m][n] = (f32x4){0.f, 0.f, 0.f, 0.f};
    bf16x8 At[4][2], B0[2][2], B1[2][2];
    const char* cA = panel_base(g.A, cur.pm, g.lda, g.dilA, K); const char* cB = panel_base(g.Bt, cur.pn, g.ldb, g.dilB, K);
    PG8_STAGE(PG8_SB(0, 0), cB, voffB); PG8_STAGE(PG8_SA(0, 0), cA, voffA); PG8_STAGE(PG8_SB(0, 1), cB + hstepB, voffB); PG8_STAGE(PG8_SA(0, 1), cA + hstepA, voffA);
    if (wr == 1) PG8_BAR;
    PG8_WAIT_V(4); PG8_BAR;
    PG8_STAGE(PG8_SB(1, 0), cB + kstep, voffB); PG8_STAGE(PG8_SA(1, 0), cA + kstep, voffA); PG8_STAGE(PG8_SB(1, 1), cB + hstepB + kstep, voffB);
    PG8_WAIT_V(6); PG8_BAR;
    for (;;) {
        const bool has_next = S.next(ui + 1, nxt);
        const char* nA = has_next ? panel_base(g.A, nxt.pm, g.lda, g.dilA, K) : cA; const char* nB = has_next ? panel_base(g.Bt, nxt.pn, g.ldb, g.dilB, K) : cB;
        for (int t = 0; t < nt; t += 2) {
            const bool last = (t == nt - 2);
            const char* a1 = cA + (size_t)(t + 1) * kstep;
            const char* a2 = last ? nA : cA + (size_t)(t + 2) * kstep; const char* b2 = last ? nB : cB + (size_t)(t + 2) * kstep;
            const char* a3 = a2 + kstep; const char* b3 = b2 + kstep;
            PG8_LDB(B0, 0, 0); PG8_SCHED; PG8_LDA(At, 0, 0); PG8_STAGE(PG8_SA(1, 1), a1 + hstepA, voffA);
            PG8_WAIT_L(8); PG8_BAR; PG8_WAIT_L(0); PG8_MMA(0, 0, At, B0); PG8_BAR; PG8_SCHED;
            PG8_LDB(B1, 0, 1); PG8_STAGE(PG8_SB(0, 0), b2, voffB);
            PG8_BAR; PG8_WAIT_L(0); PG8_MMA(0, 1, At, B1); PG8_BAR;
            PG8_LDA(At, 0, 1); PG8_STAGE(PG8_SA(0, 0), a2, voffA);
            PG8_BAR; PG8_WAIT_L(0); PG8_MMA(1, 0, At, B0); PG8_BAR; PG8_SCHED;
            PG8_STAGE(PG8_SB(0, 1), b2 + hstepB, voffB);
            PG8_WAIT_V(6); PG8_BAR; PG8_MMA(1, 1, At, B1); PG8_BAR;
            PG8_LDB(B0, 1, 0); PG8_SCHED; PG8_LDA(At, 1, 0); PG8_STAGE(PG8_SA(0, 1), a2 + hstepA, voffA);
            PG8_WAIT_L(8); PG8_BAR; PG8_WAIT_L(0); PG8_MMA(0, 0, At, B0); PG8_BAR; PG8_SCHED;
            PG8_LDB(B1, 1, 1); PG8_STAGE(PG8_SB(1, 0), b3, voffB);
            PG8_BAR; PG8_WAIT_L(0); PG8_MMA(0, 1, At, B1); PG8_BAR;
            PG8_LDA(At, 1, 1); PG8_STAGE(PG8_SA(1, 0), a3, voffA);
            PG8_BAR; PG8_WAIT_L(0); PG8_MMA(1, 0, At, B0); PG8_BAR; PG8_SCHED;
            PG8_STAGE(PG8_SB(1, 1), b3 + hstepB, voffB);
            PG8_WAIT_V(6); PG8_BAR; PG8_MMA(1, 1, At, B1); PG8_BAR;
        }
        E(acc, cur, wr, wc, fr, fq);
        if (!has_next) break;
#pragma unroll
        for (int a = 0; a < 2; ++a)
#pragma unroll
            for (int b = 0; b < 2; ++b)
#pragma unroll
                for (int m = 0; m < 4; ++m)
#pragma unroll
                    for (int n = 0; n < 2; ++n) acc[a][b][m][n] = (f32x4){0.f, 0.f, 0.f, 0.f};
        cur = nxt; cA = nA; cB = nB; ++ui;
    }
    PG8_WAIT_V(0);
    if (wr == 0) PG8_BAR;
    PG8_BAR;
#undef PG8_SA
#undef PG8_SB
#undef PG8_STAGE
#undef PG8_LDA
#undef PG8_LDB
#undef PG8_MMA
#undef PG8_WAIT_V
#undef PG8_WAIT_L
#undef PG8_BAR
#undef PG8_SCHED
}
}

struct EpiBf16 {
    static constexpr bool PERM = true;
    __device__ __forceinline__ void touch(const pg8::Unit&, LAS unsigned*, int) const {}
    bf16_t* O; bf16_t* O2; size_t ldc; int ACT;
    __device__ __forceinline__ void operator()(const f32x4 (&acc)[2][2][4][2], const pg8::Unit& u, int wr, int wc, int fr, int fq) const {
        const int row0 = u.pm * 256 + wr * 64 + fr, col0 = u.pn * 256 + wc * 32 + 8 * fq;
        if (ACT == 6) {
            const int pn = u.pn;
            if (pn < 12) { const int gq = pn >> 2, sh = 2 * gq; bf16_t* Og = O + (size_t)gq * T * 1024;
#pragma unroll
                for (int ai = 0; ai < 2; ++ai)
#pragma unroll
                    for (int m = 0; m < 4; ++m) { const int r = row0 + ai * 128 + m * 16, b = r >> 12, sq = r & 4095, pos = ((sq & ((1 << sh) - 1)) << (12 - sh)) + (sq >> sh);
                        bf16_t* rowp = Og + ((size_t)(b * 8 + (pn & 3) * 2) * 4096 + pos) * 128 + wc * 32 + 8 * fq;
#pragma unroll
                        for (int bj = 0; bj < 2; ++bj) { const f32x4 v0 = acc[ai][bj][m][0], v1 = acc[ai][bj][m][1];
                            u32x4 w; w.x = cvt_pk_bf16(v0[0], v0[1]); w.y = cvt_pk_bf16(v0[2], v0[3]); w.z = cvt_pk_bf16(v1[0], v1[1]); w.w = cvt_pk_bf16(v1[2], v1[3]);
                            *(u32x4*)(rowp + (size_t)bj * 4096 * 128) = w; } }
            } else { bf16_t* Oz = O2 + (pn - 12) * 256 + wc * 32 + 8 * fq;
#pragma unroll
                for (int ai = 0; ai < 2; ++ai)
#pragma unroll
                    for (int m = 0; m < 4; ++m) { bf16_t* rowp = Oz + (size_t)(row0 + ai * 128 + m * 16) * 1024;
#pragma unroll
                        for (int bj = 0; bj < 2; ++bj) { f32x4 v0 = acc[ai][bj][m][0], v1 = acc[ai][bj][m][1];
#pragma unroll
                            for (int j = 0; j < 4; ++j) { v0[j] = silu_f(v0[j]); v1[j] = silu_f(v1[j]); }
                            u32x4 w; w.x = cvt_pk_bf16(v0[0], v0[1]); w.y = cvt_pk_bf16(v0[2], v0[3]); w.z = cvt_pk_bf16(v1[0], v1[1]); w.w = cvt_pk_bf16(v1[2], v1[3]);
                            *(u32x4*)(rowp + bj * 128) = w; } }
            }
            return;
        }
        const bool vt = (ACT == 3), kh = (ACT == 4), qh = (ACT == 5);
        const size_t bjs = vt ? (size_t)16384 : (kh || qh) ? (size_t)4096 * 128 : (size_t)128;
#pragma unroll
        for (int ai = 0; ai < 2; ++ai)
#pragma unroll
            for (int m = 0; m < 4; ++m) { bf16_t* rowp = vt ? O + ((size_t)(((u.pn >> 4) * 2 + ai) * 32 + (u.pn & 15) * 2) * 128 + (wr * 64 + m * 16 + fr)) * 128 + wc * 32 + 8 * fq
                                                      : kh ? O + ((size_t)((u.pm >> 4) * 2) * 4096 + ((row0 + ai * 128 + m * 16) & 4095)) * 128 + wc * 32 + 8 * fq
                                                      : qh ? O + ((size_t)((u.pm >> 4) * 8 + u.pn * 2) * 4096 + ((row0 + ai * 128 + m * 16) & 4095)) * 128 + wc * 32 + 8 * fq
                                                           : O + (size_t)(row0 + ai * 128 + m * 16) * ldc + col0;
#pragma unroll
                for (int bj = 0; bj < 2; ++bj) { f32x4 v0 = acc[ai][bj][m][0], v1 = acc[ai][bj][m][1];
                    if (ACT == 2) {
#pragma unroll
                        for (int j = 0; j < 4; ++j) { v0[j] = silu_f(v0[j]); v1[j] = silu_f(v1[j]); } }
                    u32x4 w; w.x = cvt_pk_bf16(v0[0], v0[1]); w.y = cvt_pk_bf16(v0[2], v0[3]); w.z = cvt_pk_bf16(v1[0], v1[1]); w.w = cvt_pk_bf16(v1[2], v1[3]);
                    *(u32x4*)(rowp + bj * bjs) = w; } }
    }
};
struct EpiVg {
    static constexpr bool PERM = true;
    __device__ __forceinline__ void touch(const pg8::Unit&, LAS unsigned*, int) const {}
    bf16_t* O; float* part;
    __device__ __forceinline__ void operator()(const f32x4 (&acc)[2][2][4][2], const pg8::Unit& u, int wr, int wc, int fr, int fq) const {
        const int row0 = u.pm * 256 + wr * 64 + fr, col0 = u.pn * 256 + wc * 32 + 8 * fq;
        float cs[2][2][4];
#pragma unroll
        for (int bj = 0; bj < 2; ++bj)
#pragma unroll
            for (int n = 0; n < 2; ++n)
#pragma unroll
                for (int j = 0; j < 4; ++j) cs[bj][n][j] = 0.f;
#pragma unroll
        for (int ai = 0; ai < 2; ++ai)
#pragma unroll
            for (int m = 0; m < 4; ++m) { bf16_t* rowp = O + ((size_t)(u.pn * 2) * 8 + u.pm) * 32768 + (wr * 64 + fr + ai * 128 + m * 16) * 128 + wc * 32 + 8 * fq;
#pragma unroll
                for (int bj = 0; bj < 2; ++bj) { f32x4 v0 = acc[ai][bj][m][0], v1 = acc[ai][bj][m][1];
#pragma unroll
                    for (int j = 0; j < 4; j += 2) { const f32x2 a = gelu_2((f32x2){v0[j], v0[j + 1]}), b = gelu_2((f32x2){v1[j], v1[j + 1]});
                        v0[j] = a.x; v0[j + 1] = a.y; v1[j] = b.x; v1[j + 1] = b.y;
                        cs[bj][0][j] += a.x * a.x; cs[bj][0][j + 1] += a.y * a.y; cs[bj][1][j] += b.x * b.x; cs[bj][1][j + 1] += b.y * b.y; }
                    u32x4 w; w.x = cvt_pk_bf16(v0[0], v0[1]); w.y = cvt_pk_bf16(v0[2], v0[3]); w.z = cvt_pk_bf16(v1[0], v1[1]); w.w = cvt_pk_bf16(v1[2], v1[3]);
                    *(u32x4*)(rowp + (size_t)bj * 8 * 32768) = w; } }
#pragma unroll
        for (int bj = 0; bj < 2; ++bj)
#pragma unroll
            for (int n = 0; n < 2; ++n)
#pragma unroll
                for (int j = 0; j < 4; ++j) { float s = cs[bj][n][j]; s += dpp_f(s, 0xB1); s += dpp_f(s, 0x4E); s += dpp_f(s, 0x141); s += dpp_f(s, 0x140);
                    if (fr == 0) part[(size_t)(col0 + bj * 128 + 4 * n + j) * 16 + u.pm * 2 + wr] = s; }
    }
};
struct EpiUZ {
    static constexpr bool PERM = true;
    const bf16_t* mixed; bf16_t* Y;
    __device__ __forceinline__ void touch(const pg8::Unit& u, LAS unsigned* dummy, int tid) const {
        __builtin_amdgcn_global_load_lds((const unsigned*)((const char*)(mixed + (size_t)(u.pm * 256) * 2048 + u.pn * 128) + (unsigned)((tid >> 1) * 4096 + (tid & 1) * 128)), dummy, 4, 0, 0); }
    __device__ __forceinline__ void operator()(const f32x4 (&acc)[2][2][4][2], const pg8::Unit& u, int wr, int wc, int fr, int fq) const {
        const int row0 = u.pm * 256 + wr * 64 + fr, col0 = u.pn * 128 + wc * 32 + 8 * fq;
        u32x4 mxa[2][4];
#pragma unroll
        for (int ai = 0; ai < 2; ++ai)
#pragma unroll
            for (int m = 0; m < 4; ++m) mxa[ai][m] = *(const u32x4*)(mixed + (size_t)(row0 + ai * 128 + m * 16) * 2048 + col0);
#pragma unroll
        for (int ai = 0; ai < 2; ++ai)
#pragma unroll
            for (int m = 0; m < 4; ++m) { const size_t off = (size_t)(row0 + ai * 128 + m * 16) * 2048 + col0;
                const u32x4 mx = mxa[ai][m];
                const f32x4 u0 = acc[ai][0][m][0], u1 = acc[ai][0][m][1], z0 = acc[ai][1][m][0], z1 = acc[ai][1][m][1];
                const f32x2 y01 = gate_2((f32x2){u0[0], u0[1]}, (f32x2){z0[0], z0[1]}, (f32x2){bf_lo(mx.x), bf_hi(mx.x)});
                const f32x2 y23 = gate_2((f32x2){u0[2], u0[3]}, (f32x2){z0[2], z0[3]}, (f32x2){bf_lo(mx.y), bf_hi(mx.y)});
                const f32x2 y45 = gate_2((f32x2){u1[0], u1[1]}, (f32x2){z1[0], z1[1]}, (f32x2){bf_lo(mx.z), bf_hi(mx.z)});
                const f32x2 y67 = gate_2((f32x2){u1[2], u1[3]}, (f32x2){z1[2], z1[3]}, (f32x2){bf_lo(mx.w), bf_hi(mx.w)});
                const float y[8] = {y01.x, y01.y, y23.x, y23.y, y45.x, y45.y, y67.x, y67.y};
                u32x4 w; w.x = cvt_pk_bf16(y[0], y[1]); w.y = cvt_pk_bf16(y[2], y[3]); w.z = cvt_pk_bf16(y[4], y[5]); w.w = cvt_pk_bf16(y[6], y[7]);
                *(u32x4*)(Y + off) = w; }
    }
};
struct EpiOut {
    static constexpr bool PERM = false;
    const float* base; float* out; const float* gate;
    __device__ __forceinline__ void touch(const pg8::Unit& u, LAS unsigned* dummy, int tid) const {
        const char* b0 = (const char*)(base + (size_t)(u.pm * 256) * 1024 + u.pn * 256);
#pragma unroll
        for (int i = 0; i < 4; ++i) { const int line = tid + i * 512; __builtin_amdgcn_global_load_lds((const unsigned*)(b0 + (unsigned)((line >> 3) * 4096 + (line & 7) * 128)), dummy, 4, 0, 0); } }
    __device__ __forceinline__ void operator()(const f32x4 (&acc)[2][2][4][2], const pg8::Unit& u, int wr, int wc, int fr, int fq) const {
        const int row0 = u.pm * 256 + wr * 64 + fr, col0 = u.pn * 256 + wc * 32 + 4 * fq, b = u.pm >> 4;
        f32x4 gv[2][2];
#pragma unroll
        for (int bj = 0; bj < 2; ++bj)
#pragma unroll
            for (int n = 0; n < 2; ++n) gv[bj][n] = *(const f32x4*)(gate + (size_t)b * MODW + col0 + bj * 128 + n * 16);
#pragma unroll
        for (int ai = 0; ai < 2; ++ai) {
            f32x4 bs[4][2][2];
#pragma unroll
            for (int m = 0; m < 4; ++m) { const size_t off = (size_t)(row0 + ai * 128 + m * 16) * 1024 + col0;
#pragma unroll
                for (int bj = 0; bj < 2; ++bj)
#pragma unroll
                    for (int n = 0; n < 2; ++n) bs[m][bj][n] = *(const f32x4*)(base + off + bj * 128 + n * 16); }
#pragma unroll
            for (int m = 0; m < 4; ++m) { const size_t off = (size_t)(row0 + ai * 128 + m * 16) * 1024 + col0;
#pragma unroll
                for (int bj = 0; bj < 2; ++bj)
#pragma unroll
                    for (int n = 0; n < 2; ++n) *(f32x4*)(out + off + bj * 128 + n * 16) = bs[m][bj][n] + gv[bj][n] * acc[ai][bj][m][n]; }
        }
    }
};

__device__ void ada_unit(int wv, const Params& p, LAS float* lf, int unit) {
    const int tid = opaque_tid(wv);
    int set, cu;
    if (unit < 48) { set = 0; cu = unit; } else if (unit < 96) { set = 1; cu = unit - 48; } else if (unit < 128) { set = 2; cu = unit - 96; }
    else if (unit < 176) { set = 3; cu = unit - 128; } else { set = 4; cu = unit - 176; }
    const float* W; const float* bias; int ncol, modoff;
    if (set < 2) { W = p.in[2] + (size_t)set * 1024 * 3072; bias = p.in[3] + set * 3072; ncol = 3072; modoff = set * 3072; }
    else if (set == 2) { W = p.in[10]; bias = p.in[11]; ncol = 2048; modoff = 6144; }
    else { W = p.in[15] + (size_t)(set - 3) * 1024 * 3072; bias = p.in[16] + (set - 3) * 3072; ncol = 3072; modoff = 8192 + (set - 3) * 3072; }
    const float* c = p.in[1];
    for (int i = tid; i < 8192; i += 512) lf[i] = silu_f(c[i]);
    __syncthreads();
    const int w = tid >> 6, lane = tid & 63, col = cu * 64 + lane;
    float a0 = 0.f, a1 = 0.f, a2 = 0.f, a3 = 0.f, a4 = 0.f, a5 = 0.f, a6 = 0.f, a7 = 0.f;
#pragma unroll 16
    for (int k = w * 128; k < w * 128 + 128; ++k) {
        const float wv = W[(size_t)k * ncol + col];
        a0 += lf[k] * wv; a1 += lf[1024 + k] * wv; a2 += lf[2048 + k] * wv; a3 += lf[3072 + k] * wv;
        a4 += lf[4096 + k] * wv; a5 += lf[5120 + k] * wv; a6 += lf[6144 + k] * wv; a7 += lf[7168 + k] * wv;
    }
    LAS float* red = lf + 8192;
    red[(w * 8 + 0) * 64 + lane] = a0; red[(w * 8 + 1) * 64 + lane] = a1; red[(w * 8 + 2) * 64 + lane] = a2; red[(w * 8 + 3) * 64 + lane] = a3;
    red[(w * 8 + 4) * 64 + lane] = a4; red[(w * 8 + 5) * 64 + lane] = a5; red[(w * 8 + 6) * 64 + lane] = a6; red[(w * 8 + 7) * 64 + lane] = a7;
    __syncthreads();
    { const int b = w; float s = 0.f;
#pragma unroll
      for (int w2 = 0; w2 < 8; ++w2) s += red[(w2 * 8 + b) * 64 + lane];
      float* mod = (float*)(p.ws + WS_MOD);
      mod[(size_t)b * MODW + modoff + col] = s + bias[col]; }
    __syncthreads();
}

struct CT { const float* src; bf16_t* dst; int K, Nsrc, srccol0, row0, k0; };
__device__ __forceinline__ CT conv_decode(const Params& p, int tile) {
    int j = 0, tt = tile; CT c; c.K = 1024; int coloff = 0, map = 0;
    if (tt < 1024) { j = tt >> 9; tt &= 511; c.src = p.in[5] + (size_t)j * 1024 * 6144; c.dst = (bf16_t*)(p.ws + WS_WVA) + (size_t)j * 2048 * 1024; c.Nsrc = 6144; coloff = 2048; }
    else if (tt < 3072) { tt -= 1024; j = tt >> 10; tt &= 1023; c.src = p.in[5] + (size_t)j * 1024 * 6144; c.dst = (bf16_t*)(p.ws + WS_WUZ) + (size_t)j * 4096 * 1024; c.Nsrc = 6144; map = 1; }
    else if (tt < 4096) { tt -= 3072; j = tt >> 9; tt &= 511; c.src = p.in[9] + (size_t)j * 2048 * 1024; c.dst = (bf16_t*)(p.ws + WS_WOA) + (size_t)j * 1024 * 2048; c.Nsrc = 1024; c.K = 2048; }
    else if (tt < 4480) { tt -= 4096; c.src = p.in[13]; c.dst = (bf16_t*)(p.ws + WS_WKV); c.Nsrc = 1536; }
    else if (tt < 6528) { tt -= 4480; j = tt >> 10; tt &= 1023; c.src = p.in[18] + (size_t)j * 1024 * 4096; c.dst = (bf16_t*)(p.ws + WS_WQB) + (size_t)j * 4096 * 1024; c.Nsrc = 4096; }
    else { tt -= 6528; j = tt >> 8; tt &= 255; c.src = p.in[20] + (size_t)j * 1024 * 1024; c.dst = (bf16_t*)(p.ws + WS_WOB) + (size_t)j * 1024 * 1024; c.Nsrc = 1024; }
    const int kt = c.K / 64, rt = tt / kt, kc = tt % kt; c.row0 = rt * 64; c.k0 = kc * 64;
    c.srccol0 = c.row0 + coloff;
    if (map == 1) { const int pn = c.row0 >> 8, bj = (c.row0 >> 7) & 1, jj = c.row0 & 127; c.srccol0 = (bj ? 4096 : 0) + pn * 128 + jj; }
    return c;
}
__device__ __forceinline__ void conv_load(const CT& c, int tid, f32x4 (&v)[2]) {
    const int kk = tid >> 4, n4 = (tid & 15) * 4;
#pragma unroll
    for (int h = 0; h < 2; ++h) v[h] = *(const f32x4*)(c.src + (size_t)(c.k0 + kk + h * 32) * c.Nsrc + c.srccol0 + n4);
}
__device__ __forceinline__ void conv_store(LAS float* tl, const CT& c, int tid, const f32x4 (&v)[2]) {
    { const int kk = tid >> 4, n4 = (tid & 15) * 4;
#pragma unroll
      for (int h = 0; h < 2; ++h) { const int k = kk + h * 32; tl[(n4 + 0) * 65 + k] = v[h][0]; tl[(n4 + 1) * 65 + k] = v[h][1]; tl[(n4 + 2) * 65 + k] = v[h][2]; tl[(n4 + 3) * 65 + k] = v[h][3]; } }
    __syncthreads();
    { const int n = tid >> 3, k8 = (tid & 7) * 8; const LAS float* r = tl + n * 65 + k8;
      u32x4 w; w.x = cvt_pk_bf16(r[0], r[1]); w.y = cvt_pk_bf16(r[2], r[3]); w.z = cvt_pk_bf16(r[4], r[5]); w.w = cvt_pk_bf16(r[6], r[7]);
      *(u32x4*)(c.dst + (size_t)(c.row0 + n) * c.K + c.k0 + k8) = w; }
    __syncthreads();
}

__device__ void phase0(int wv, const Params& p, LAS unsigned char* lds) {
    LAS float* lf = (LAS float*)lds;
    const int bx = opaque_bid(), tid = opaque_tid(wv);
    f32x4 vcur[2], vnxt[2];
    CT cur = conv_decode(p, bx);
    conv_load(cur, tid, vcur);
    if (bx < 224) ada_unit(wv, p, lf, bx);
    for (int tile = bx; tile < 7040; tile += gridDim.x) {
        const int nt = tile + gridDim.x; CT nxt = cur;
        if (nt < 7040) { nxt = conv_decode(p, nt); conv_load(nxt, tid, vnxt); }
        conv_store(lf, cur, tid, vcur);
        cur = nxt; vcur[0] = vnxt[0]; vcur[1] = vnxt[1];
    }
}

__device__ void norm_phase(int wv, const float* x, const float* g, const float* mod  , bf16_t* dst, const float* g2 = nullptr, const float* mod2 = nullptr, bf16_t* dst2 = nullptr) {
    const int tid0 = opaque_tid(wv), w = tid0 >> 6, lane = tid0 & 63;
    for (int row = (opaque_bid() * 8 + w) * 4; row < T; row += gridDim.x * 32) {
        const int b = row >> 12; const float* xr = x + (size_t)row * 1024;
        f32x4 v[4][4]; float ss[4];
#pragma unroll
        for (int r = 0; r < 4; ++r)
#pragma unroll
            for (int j = 0; j < 4; ++j) v[r][j] = *(const f32x4*)(xr + r * 1024 + lane * 4 + j * 256);
#pragma unroll
        for (int r = 0; r < 4; ++r) { float q = 0.f;
#pragma unroll
            for (int j = 0; j < 4; ++j) q += v[r][j][0] * v[r][j][0] + v[r][j][1] * v[r][j][1] + v[r][j][2] * v[r][j][2] + v[r][j][3] * v[r][j][3];
            q += dpp_f(q, 0xB1); q += dpp_f(q, 0x4E); q += dpp_f(q, 0x141); q += dpp_f(q, 0x140); q += shx(q, 16, lane); q += shx(q, 32, lane);
            ss[r] = rsqrtf(q * (1.0f / 1024.0f) + EPS); }
        const float* mb = mod + (size_t)b * MODW;
#pragma unroll
        for (int j = 0; j < 4; ++j) { const int col = lane * 4 + j * 256;
            const f32x4 gg = *(const f32x4*)(g + col), sh = *(const f32x4*)(mb + col), sc = *(const f32x4*)(mb + 1024 + col);
            const f32x4 gs = gg * (sc + 1.0f);
#pragma unroll
            for (int r = 0; r < 4; ++r) { const f32x4 h = v[r][j] * ss[r] * gs + sh;
                u32x2 wv; wv.x = cvt_pk_bf16(h[0], h[1]); wv.y = cvt_pk_bf16(h[2], h[3]);
                *(u32x2*)(dst + (size_t)(row + r) * 1024 + col) = wv; }
            if (dst2) { const float* mb2 = mod2 + (size_t)b * MODW;
                const f32x4 gg2 = *(const f32x4*)(g2 + col), sh2 = *(const f32x4*)(mb2 + col), sc2 = *(const f32x4*)(mb2 + 1024 + col);
                const f32x4 gs2 = gg2 * (sc2 + 1.0f);
#pragma unroll
                for (int r = 0; r < 4; ++r) { const f32x4 h = v[r][j] * ss[r] * gs2 + sh2;
                    u32x2 wv; wv.x = cvt_pk_bf16(h[0], h[1]); wv.y = cvt_pk_bf16(h[2], h[3]);
                    *(u32x2*)(dst2 + (size_t)(row + r) * 1024 + col) = wv; } } }
    }
}

__device__ void mix_phase(int wv, const Params& p, LAS unsigned char* lds, int l) {
    const int tid = opaque_tid(wv), w = __builtin_amdgcn_readfirstlane(tid >> 6), lane = tid & 63, fr = lane & 15, fq = lane >> 4;
    const bf16_t* VgT = (const bf16_t*)(p.ws + WS_BUF1); bf16_t* mixed = (bf16_t*)(p.ws + WS_BUF2);
    const float* part = (const float*)(p.ws + WS_PART);
    const float* Wsp = p.in[7] + (size_t)l * 8 * 128 * 128; const float* bsp = p.in[8] + (size_t)l * 8 * 128; const float* sgu = p.in[6] + (size_t)l * 2048;
    LAS float* rs = (LAS float*)(lds + 32768);
    bf16x8 afN[2][4]; f32x4 wsN[4][2]; f32x4 ptN[4];
#define MIX_LOAD(U) do { const int g_ = (U) & 7, c_ = (U) >> 3; \
        _Pragma("unroll") for (int mt = 0; mt < 2; ++mt) _Pragma("unroll") for (int ks = 0; ks < 4; ++ks) \
            afN[mt][ks] = *(const bf16x8*)(VgT + ((size_t)c_ * 8 + g_) * 32768 + (w * 32 + (fr >> 2) * 8 + mt * 4 + (fr & 3)) * 128 + ks * 32 + fq * 8); \
        _Pragma("unroll") for (int it = 0; it < 4; ++it) { const int idx = it * 512 + tid, t = idx >> 4, cs = idx & 15; const float* wp = Wsp + ((size_t)g_ * 128 + t) * 128 + cs * 8; \
            wsN[it][0] = *(const f32x4*)wp; wsN[it][1] = *(const f32x4*)(wp + 4); } \
        if (tid < 128) { const float* pp = part + (size_t)(c_ * 128 + tid) * 16; _Pragma("unroll") for (int i = 0; i < 4; ++i) ptN[i] = *(const f32x4*)(pp + i * 4); } } while (0)
    int u = opaque_bid();
    if (u < 2048) MIX_LOAD(u);
    for (; u < 2048; u += gridDim.x) {
        const int g = u & 7, c = u >> 3;
        bf16x8 af[2][4]; f32x4 ws[4][2];
#pragma unroll
        for (int mt = 0; mt < 2; ++mt)
#pragma unroll
            for (int ks = 0; ks < 4; ++ks) af[mt][ks] = afN[mt][ks];
#pragma unroll
        for (int it = 0; it < 4; ++it) { ws[it][0] = wsN[it][0]; ws[it][1] = wsN[it][1]; }
        __syncthreads();
        if (tid < 128) { float s = 0.f;
#pragma unroll
            for (int i = 0; i < 4; ++i) { const f32x4 q = ptN[i]; s += q[0] + q[1] + q[2] + q[3]; }
            rs[tid] = rsqrtf(s * (1.0f / 2048.0f) + EPS); }
        __syncthreads();
#pragma unroll
        for (int it = 0; it < 4; ++it) { const int idx = it * 512 + tid, t = idx >> 4, cs = idx & 15, s0 = cs * 8;
            const f32x4 w0 = ws[it][0], w1 = ws[it][1];
            float v[8];
#pragma unroll
            for (int e = 0; e < 4; ++e) { v[e] = (s0 + e <= t) ? w0[e] * rs[s0 + e] : 0.f; v[4 + e] = (s0 + 4 + e <= t) ? w1[e] * rs[s0 + 4 + e] : 0.f; }
            u32x4 pk; pk.x = cvt_pk_bf16(v[0], v[1]); pk.y = cvt_pk_bf16(v[2], v[3]); pk.z = cvt_pk_bf16(v[4], v[5]); pk.w = cvt_pk_bf16(v[6], v[7]);
            *(LAS u32x4*)(lds + t * 256 + ((cs ^ (t & 15)) << 4)) = pk; }
        float bbv[8]; f32x4 sg0, sg1;
#pragma unroll
        for (int nt = 0; nt < 8; ++nt) bbv[nt] = bsp[g * 128 + nt * 16 + fr];
        { const int e0 = g * 256 + w * 32 + fq * 8; sg0 = *(const f32x4*)(sgu + e0); sg1 = *(const f32x4*)(sgu + e0 + 4); }
        if (u + (int)gridDim.x < 2048) MIX_LOAD(u + (int)gridDim.x);
        __syncthreads();
#pragma unroll
        for (int nt = 0; nt < 8; ++nt) {
            f32x4 acc0 = {0.f, 0.f, 0.f, 0.f}, acc1 = {0.f, 0.f, 0.f, 0.f};
#pragma unroll
            for (int ks = 0; ks < 4; ++ks) {
                if (ks * 32 <= nt * 16 + 15) {
                    const bf16x8 bfr = *(const LAS bf16x8*)(lds + (nt * 16 + fr) * 256 + (((ks * 4 + fq) ^ fr) << 4));
                    acc0 = __builtin_amdgcn_mfma_f32_16x16x32_bf16(af[0][ks], bfr, acc0, 0, 0, 0);
                    acc1 = __builtin_amdgcn_mfma_f32_16x16x32_bf16(af[1][ks], bfr, acc1, 0, 0, 0);
                }
            }
            const int tl = nt * 16 + fr; const size_t token = (size_t)c * 128 + tl; const float bb = bbv[nt];
            { const int e0 = g * 256 + w * 32 + fq * 8;
              u32x4 wv; wv.x = cvt_pk_bf16(acc0[0] * sg0[0] + bb, acc0[1] * sg0[1] + bb); wv.y = cvt_pk_bf16(acc0[2] * sg0[2] + bb, acc0[3] * sg0[3] + bb);
              wv.z = cvt_pk_bf16(acc1[0] * sg1[0] + bb, acc1[1] * sg1[1] + bb); wv.w = cvt_pk_bf16(acc1[2] * sg1[2] + bb, acc1[3] * sg1[3] + bb);
              *(u32x4*)(mixed + token * 2048 + e0) = wv; }
        }
    }
#undef MIX_LOAD
}

constexpr int VPITCH = 528;
__device__ void attn_phase(int wv, const Params& p, LAS unsigned char* lds, int l, int mode) {
    const int tid = opaque_tid(wv), w = __builtin_amdgcn_readfirstlane(tid >> 6), lane = tid & 63, fr = lane & 15, fq = lane >> 4;
    LAS unsigned char* Ks = lds; LAS unsigned char* Vs = lds + 65536;
    const float* qg = p.in[19] + (size_t)l * 128; const float* kg = p.in[14];
    float* LSE = (float*)(p.ws + WS_LSE);
    int u0 = opaque_bid(); { const int Gx = gridDim.x; if ((Gx & 7) == 0) u0 = (u0 & 7) * (Gx >> 3) + (u0 >> 3); }
    for (int u = (mode ? 1024 : 0) + u0; u < (mode ? 1536 : 1024); u += gridDim.x) {
        const int k = u & 1; int t = u >> 1; const int blk = ((t & 31) + 5 * (u / (int)gridDim.x)) & 31; t >>= 5; const int b = t & 7, g = t >> 3;
        const int dsh = 2 * g, nbk = 32 >> dsh, n = blk & (nbk - 1);
        bf16_t* QO = (bf16_t*)(p.ws + WS_QO) + (size_t)g * T * 1024;
        const bf16_t* Kd = (const bf16_t*)(p.ws + WS_KD) + (size_t)g * T * 256;
        const bf16_t* Vt = (const bf16_t*)(p.ws + WS_VT) + (size_t)g * 256 * T;
        const size_t row0 = (size_t)b * SEQ + blk * 128;
        int tl = tid; asm volatile("" : "+v"(tl));
        const int lfr = tl & 15, lfq = (tl >> 4) & 3;
        const int j = k * 4 + (w >> 1);
        const char* qbase = (const char*)(QO + ((size_t)(b * 8 + j) * 4096 + blk * 128 + (w & 1) * 64) * 128);
        const unsigned qoff = (unsigned)(lfr * 256 + lfq * 16);
        u32x4 raw[2][4];
#pragma unroll
        for (int qt = 0; qt < 2; ++qt)
#pragma unroll
            for (int ks = 0; ks < 4; ++ks) raw[qt][ks] = *(const u32x4*)(qbase + (qoff + qt * 4096 + ks * 64));
        __syncthreads();
        {
            const char* kbase = (const char*)(Kd + ((size_t)(b * 2 + k) * 4096 + blk * 128 - 128) * 128);
            const char* vbase = (const char*)(Vt + ((size_t)((b * 2 + k) * 32 + blk - 1) * 128) * 128);
            u32x4 kraw[8], vraw[8];
#pragma unroll
            for (int it = 0; it < 8; ++it) { const int idx = it * 512 + tl; int row = idx >> 4; const int c = idx & 15; if (n == 0 && it < 4) row += 128;
                kraw[it] = *(const u32x4*)(kbase + (unsigned)(row * 256 + c * 16)); }
#pragma unroll
            for (int it = 0; it < 8; ++it) { const int idx = it * 512 + tl, h = idx >> 5; int c = idx & 31; if (n == 0 && c < 16) c += 16;
                vraw[it] = *(const u32x4*)(vbase + (unsigned)((c >> 4) * 32768 + h * 256 + (c & 15) * 16)); }
#pragma unroll
            for (int it = 0; it < 8; ++it) { const int idx = it * 512 + tl, row = idx >> 4, c = idx & 15; const u32x4 raw = kraw[it];
                float v[8]; v[0] = bf_lo(raw.x); v[1] = bf_hi(raw.x); v[2] = bf_lo(raw.y); v[3] = bf_hi(raw.y); v[4] = bf_lo(raw.z); v[5] = bf_hi(raw.z); v[6] = bf_lo(raw.w); v[7] = bf_hi(raw.w);
                float ss = 0.f;
#pragma unroll
                for (int e = 0; e < 8; ++e) ss += v[e] * v[e];
                ss += dpp_f(ss, 0xB1); ss += dpp_f(ss, 0x4E); ss += dpp_f(ss, 0x141); ss += dpp_f(ss, 0x140);
                const float rstd = rsqrtf(ss * (1.0f / 128.0f) + EPS);
                u32x4 pk; pk.x = cvt_pk_bf16(v[0] * rstd, v[1] * rstd); pk.y = cvt_pk_bf16(v[2] * rstd, v[3] * rstd); pk.z = cvt_pk_bf16(v[4] * rstd, v[5] * rstd); pk.w = cvt_pk_bf16(v[6] * rstd, v[7] * rstd);
                *(LAS u32x4*)(Ks + row * 256 + ((c ^ (row & 15)) << 4)) = pk; }
#pragma unroll
            for (int it = 0; it < 8; ++it) { const int idx = it * 512 + tl, h = idx >> 5, c = idx & 31;
                *(LAS u32x4*)(Vs + h * VPITCH + c * 16) = vraw[it]; }
        }
        __syncthreads();
        const float slope = exp2f(-8.0f * (float)(g * 8 + j + 1) / 24.0f);
        const float nsl = -slope * (float)(1 << dsh) * LOG2E;
#pragma unroll 1
        for (int sub = 0; sub < 2; ++sub) {
            const int i0 = (w & 1) * 64 + sub * 32;
            bf16x8 qf[2][4]; float mq[2];
            {
                if (sub == 1) {
#pragma unroll
                    for (int qt = 0; qt < 2; ++qt)
#pragma unroll
                        for (int ks = 0; ks < 4; ++ks) raw[qt][ks] = *(const u32x4*)(qbase + (qoff + 8192 + qt * 4096 + ks * 64));
                }
                float rq[2];
#pragma unroll
                for (int qt = 0; qt < 2; ++qt) { float ss = 0.f;
#pragma unroll
                    for (int ks = 0; ks < 4; ++ks) { const u32x4 r = raw[qt][ks];
                        ss += bf_lo(r.x) * bf_lo(r.x) + bf_hi(r.x) * bf_hi(r.x) + bf_lo(r.y) * bf_lo(r.y) + bf_hi(r.y) * bf_hi(r.y) + bf_lo(r.z) * bf_lo(r.z) + bf_hi(r.z) * bf_hi(r.z) + bf_lo(r.w) * bf_lo(r.w) + bf_hi(r.w) * bf_hi(r.w); }
                    ss += shx(ss, 16, lane); ss += shx(ss, 32, lane);
                    rq[qt] = rsqrtf(ss * (1.0f / 128.0f) + EPS) * (0.08838834764831845f * LOG2E); }
                float q2[2] = {0.f, 0.f};
#pragma unroll
                for (int ks = 0; ks < 4; ++ks) { const int h0 = ks * 32 + fq * 8;
                    const f32x4 qa = *(const f32x4*)(qg + h0), qb = *(const f32x4*)(qg + h0 + 4), ka = *(const f32x4*)(kg + h0), kb = *(const f32x4*)(kg + h0 + 4);
                    const f32x4 ga = qa * ka, gb = qb * kb;
#pragma unroll
                    for (int qt = 0; qt < 2; ++qt) { const u32x4 r = raw[qt][ks]; const float sc = rq[qt];
                        float v[8]; v[0] = bf_lo(r.x) * sc * ga[0]; v[1] = bf_hi(r.x) * sc * ga[1]; v[2] = bf_lo(r.y) * sc * ga[2]; v[3] = bf_hi(r.y) * sc * ga[3];
                        v[4] = bf_lo(r.z) * sc * gb[0]; v[5] = bf_hi(r.z) * sc * gb[1]; v[6] = bf_lo(r.w) * sc * gb[2]; v[7] = bf_hi(r.w) * sc * gb[3];
#pragma unroll
                        for (int e = 0; e < 8; ++e) q2[qt] += v[e] * v[e];
                        u32x4 pk; pk.x = cvt_pk_bf16(v[0], v[1]); pk.y = cvt_pk_bf16(v[2], v[3]); pk.z = cvt_pk_bf16(v[4], v[5]); pk.w = cvt_pk_bf16(v[6], v[7]);
                        qf[qt][ks] = __builtin_bit_cast(bf16x8, pk); } }
#pragma unroll
                for (int qt = 0; qt < 2; ++qt) { float t2 = q2[qt]; t2 += shx(t2, 16, lane); t2 += shx(t2, 32, lane); mq[qt] = sqrtf(t2) * (11.313708499f * 1.01f) + 0.05f; }
            }
            float lrun[2] = {0.f, 0.f};
            f32x4 oacc[8][2];
#pragma unroll
            for (int ht = 0; ht < 8; ++ht) { oacc[ht][0] = (f32x4){0.f, 0.f, 0.f, 0.f}; oacc[ht][1] = (f32x4){0.f, 0.f, 0.f, 0.f}; }
            const int kc0 = i0 >> 5; int kc_lo = kc0; const int kc_hi = kc0 + 5; if (n == 0 && kc_lo < 4) kc_lo = 4;
            bf16x8 kfr[2][4];
#define LOADK(KC) do { _Pragma("unroll") for (int kt = 0; kt < 2; ++kt) _Pragma("unroll") for (int ks = 0; ks < 4; ++ks) \
                kfr[kt][ks] = *(const LAS bf16x8*)(Ks + ((KC) * 32 + kt * 16 + fr) * 256 + (((ks * 4 + fq) ^ fr) << 4)); } while (0)
#pragma unroll 1
            for (int kc = kc_lo; kc < kc_hi; ++kc) {
                LOADK(kc);
                u32x2 vlo[8], vhi[8];
#pragma unroll
                for (int ht = 0; ht < 4; ++ht) { const LAS unsigned char* vp = Vs + ((ht >> 1) * 32 + (fr >> 2) * 8 + (ht & 1) * 4 + (fr & 3)) * VPITCH + (kc * 32 + fq * 4) * 2;
                    vlo[ht] = *(const LAS u32x2*)vp; vhi[ht] = *(const LAS u32x2*)(vp + 32); }
                __builtin_amdgcn_sched_barrier(0);
                f32x4 sacc[2][2];
#pragma unroll
                for (int qt = 0; qt < 2; ++qt) { const float c0 = nsl * (float)(128 + i0 + qt * 16 + fr - kc * 32 - fq * 4) - mq[qt];
#pragma unroll
                    for (int kt = 0; kt < 2; ++kt)
#pragma unroll
                        for (int e = 0; e < 4; ++e) sacc[kt][qt][e] = c0 - nsl * (float)(kt * 16 + e); }
#pragma unroll
                for (int ks = 0; ks < 4; ++ks)
#pragma unroll
                    for (int kt = 0; kt < 2; ++kt) {
                        sacc[kt][0] = __builtin_amdgcn_mfma_f32_16x16x32_bf16(kfr[kt][ks], qf[0][ks], sacc[kt][0], 0, 0, 0);
                        sacc[kt][1] = __builtin_amdgcn_mfma_f32_16x16x32_bf16(kfr[kt][ks], qf[1][ks], sacc[kt][1], 0, 0, 0); }
                __builtin_amdgcn_sched_barrier(0);
#pragma unroll
                for (int ht = 4; ht < 8; ++ht) { const LAS unsigned char* vp = Vs + ((ht >> 1) * 32 + (fr >> 2) * 8 + (ht & 1) * 4 + (fr & 3)) * VPITCH + (kc * 32 + fq * 4) * 2;
                    vlo[ht] = *(const LAS u32x2*)vp; vhi[ht] = *(const LAS u32x2*)(vp + 32); }
                __builtin_amdgcn_sched_barrier(0);
                const bool edge = (kc == kc0) || (kc == kc0 + 4);
                bf16x8 pf[2];
#pragma unroll
                for (int qt = 0; qt < 2; ++qt) {
                    float ps = 0.f;
                    if (edge) {
                        const int iq = i0 + qt * 16 + fr;
#pragma unroll
                        for (int kt = 0; kt < 2; ++kt)
#pragma unroll
                            for (int e = 0; e < 4; ++e) { const int jk = kc * 32 + kt * 16 + fq * 4 + e, dq = 128 + iq - jk;
                                const float pv = (dq >= 0 && dq <= 128) ? ex2(sacc[kt][qt][e]) : 0.f; sacc[kt][qt][e] = pv; ps += pv; }
                    } else {
#pragma unroll
                        for (int kt = 0; kt < 2; ++kt)
#pragma unroll
                            for (int e = 0; e < 4; ++e) { const float pv = ex2(sacc[kt][qt][e]); sacc[kt][qt][e] = pv; ps += pv; }
                    }
                    lrun[qt] += ps;
                    u32x4 pk; pk.x = cvt_pk_bf16(sacc[0][qt][0], sacc[0][qt][1]); pk.y = cvt_pk_bf16(sacc[0][qt][2], sacc[0][qt][3]);
                    pk.z = cvt_pk_bf16(sacc[1][qt][0], sacc[1][qt][1]); pk.w = cvt_pk_bf16(sacc[1][qt][2], sacc[1][qt][3]);
                    pf[qt] = __builtin_bit_cast(bf16x8, pk);
                }
#pragma unroll
                for (int ht = 0; ht < 8; ++ht) {
                    u32x4 vv; vv.x = vlo[ht].x; vv.y = vlo[ht].y; vv.z = vhi[ht].x; vv.w = vhi[ht].y;
                    const bf16x8 vf = __builtin_bit_cast(bf16x8, vv);
                    oacc[ht][0] = __builtin_amdgcn_mfma_f32_16x16x32_bf16(vf, pf[0], oacc[ht][0], 0, 0, 0);
                    oacc[ht][1] = __builtin_amdgcn_mfma_f32_16x16x32_bf16(vf, pf[1], oacc[ht][1], 0, 0, 0); }
            }
#undef LOADK
#pragma unroll
            for (int qt = 0; qt < 2; ++qt) {
                float lt = lrun[qt]; lt += shx(lt, 16, lane); lt += shx(lt, 32, lane);
                const float inv = 1.0f / lt; const size_t row = row0 + i0 + qt * 16 + fr;
                char* obase = (char*)qbase + (unsigned)(lfr * 256 + lfq * 16 + sub * 8192 + qt * 4096);
                const float lse_here = (mq[qt] + log2f(lt)) * LN2;
                if (mode == 0) {
#pragma unroll
                    for (int pp = 0; pp < 4; ++pp) { const f32x4 o0 = oacc[2 * pp][qt] * inv, o1 = oacc[2 * pp + 1][qt] * inv;
                        u32x4 wv; wv.x = cvt_pk_bf16(o0[0], o0[1]); wv.y = cvt_pk_bf16(o0[2], o0[3]); wv.z = cvt_pk_bf16(o1[0], o1[1]); wv.w = cvt_pk_bf16(o1[2], o1[3]);
                        *(u32x4*)(obase + pp * 64) = wv; }
                    if (fq == 0) LSE[((size_t)g * T + row) * 8 + j] = lse_here;
                } else {
                    const int pos = (int)(row - (size_t)b * SEQ), sq = (pos & 255) * 16 + (pos >> 8), p1 = (sq & 3) * 1024 + (sq >> 2);
                    const bf16_t* o0b = (const bf16_t*)(p.ws + WS_QO) + (size_t)(b * 8 + j) * 4096 * 128; const bf16_t* o1b = o0b + (size_t)T * 1024;
                    const bf16_t* zb = (const bf16_t*)(p.ws + WS_ZS) + (size_t)b * SEQ * 1024 + j * 128; bf16_t* yb = (bf16_t*)(p.ws + WS_HB) + (size_t)b * SEQ * 1024 + j * 128;
                    const unsigned oa = (unsigned)(sq * 128 + lfq * 8), ob = (unsigned)(p1 * 128 + lfq * 8), oz = (unsigned)(sq * 1024 + lfq * 8);
                    const float l0 = LSE[((size_t)b * SEQ + sq) * 8 + j], l1 = LSE[((size_t)T + (size_t)b * SEQ + p1) * 8 + j];
                    const float mx = fmaxf(l0, fmaxf(l1, lse_here));
                    float e0 = ex2((l0 - mx) * LOG2E), e1 = ex2((l1 - mx) * LOG2E), e2 = ex2((lse_here - mx) * LOG2E);
                    const float ei = 1.0f / (e0 + e1 + e2); e0 *= ei; e1 *= ei; e2 *= ei * inv;
#pragma unroll
                    for (int ph2 = 0; ph2 < 2; ++ph2) {
                        u32x4 a0[2], a1[2], zz[2];
#pragma unroll
                        for (int q2 = 0; q2 < 2; ++q2) { const int pp = ph2 * 2 + q2; a0[q2] = *(const u32x4*)(o0b + (oa + pp * 32)); a1[q2] = *(const u32x4*)(o1b + (ob + pp * 32)); zz[q2] = *(const u32x4*)(zb + (oz + pp * 32)); }
#pragma unroll
                        for (int q2 = 0; q2 < 2; ++q2) { const int pp = ph2 * 2 + q2; const f32x4 o0 = oacc[2 * pp][qt], o1 = oacc[2 * pp + 1][qt]; u32x4 y;
#define MRG2(c, va, vb) cvt_pk_bf16((e0 * bf_lo(a0[q2].c) + e1 * bf_lo(a1[q2].c) + e2 * (va)) * bf_lo(zz[q2].c), (e0 * bf_hi(a0[q2].c) + e1 * bf_hi(a1[q2].c) + e2 * (vb)) * bf_hi(zz[q2].c))
                            y.x = MRG2(x, o0[0], o0[1]); y.y = MRG2(y, o0[2], o0[3]); y.z = MRG2(z, o1[0], o1[1]); y.w = MRG2(w, o1[2], o1[3]);
#undef MRG2
                            *(u32x4*)(yb + (oz + pp * 32)) = y; }
                    }
                }
            }
        }
    }
}

__device__ void merge_phase(int wv, const Params& p) {
    const int tid0 = opaque_tid(wv), w = tid0 >> 6, lane = tid0 & 63;
    const bf16_t* QO = (const bf16_t*)(p.ws + WS_QO); const float* LSE = (const float*)(p.ws + WS_LSE);
    const bf16_t* Zs = (const bf16_t*)(p.ws + WS_ZS); bf16_t* Y = (bf16_t*)(p.ws + WS_HB);
    for (int t = opaque_bid() * 8 + w; t < T; t += gridDim.x * 8) {
        const int b = t >> 12, s = t & 4095;
        const size_t r0 = (size_t)t, r1 = (size_t)b * SEQ + (s & 3) * 1024 + (s >> 2), r2 = (size_t)b * SEQ + (s & 15) * 256 + (s >> 4);
        float l0[2], l1[2], l2[2]; u32x4 o0[2], o1[2], o2[2], z[2];
#pragma unroll
        for (int i = 0; i < 2; ++i) {
            const int col = lane * 8 + i * 512, head = col >> 7;
            l0[i] = LSE[(r0) * 8 + head]; l1[i] = LSE[((size_t)T + r1) * 8 + head]; l2[i] = LSE[((size_t)2 * T + r2) * 8 + head];
            { const size_t hb = (size_t)(b * 8 + head) * 4096; const int hh = col & 127;
              o0[i] = *(const u32x4*)(QO + (hb + (r0 & 4095)) * 128 + hh); o1[i] = *(const u32x4*)(QO + (size_t)T * 1024 + (hb + (r1 & 4095)) * 128 + hh); o2[i] = *(const u32x4*)(QO + (size_t)2 * T * 1024 + (hb + (r2 & 4095)) * 128 + hh); }
            z[i] = *(const u32x4*)(Zs + (size_t)t * 1024 + col);
        }
#pragma unroll
        for (int i = 0; i < 2; ++i) {
            const int col = lane * 8 + i * 512;
            const float mx = fmaxf(l0[i], fmaxf(l1[i], l2[i]));
            float e0 = ex2((l0[i] - mx) * LOG2E), e1 = ex2((l1[i] - mx) * LOG2E), e2 = ex2((l2[i] - mx) * LOG2E);
            const float inv = 1.0f / (e0 + e1 + e2); e0 *= inv; e1 *= inv; e2 *= inv;
            u32x4 y;
#define MRG(c) cvt_pk_bf16((e0 * bf_lo(o0[i].c) + e1 * bf_lo(o1[i].c) + e2 * bf_lo(o2[i].c)) * bf_lo(z[i].c), (e0 * bf_hi(o0[i].c) + e1 * bf_hi(o1[i].c) + e2 * bf_hi(o2[i].c)) * bf_hi(z[i].c))
            y.x = MRG(x); y.y = MRG(y); y.z = MRG(z); y.w = MRG(w);
#undef MRG
            *(u32x4*)(Y + (size_t)t * 1024 + col) = y;
        }
    }
}

#define XB_TMO      128
#define XB_XCNT(j)  (256  + 64 * (j))
#define XB_XSUB(j)  (1280 + 64 * (j))
#define XB_XGEN(j)  (2304 + 64 * (j))
#define XB_TOP      3328
#define XB_TOPGEN   3392
#define XCD_BAR_WORDS 3456
#define XB_SPIN_CAP (1u << 22)
__device__ __forceinline__ unsigned xb_ld(unsigned* p)              { return __hip_atomic_load(p, __ATOMIC_RELAXED, __HIP_MEMORY_SCOPE_AGENT); }
__device__ __forceinline__ unsigned xb_add(unsigned* p, unsigned v) { return __hip_atomic_fetch_add(p, v, __ATOMIC_RELAXED, __HIP_MEMORY_SCOPE_AGENT); }
__device__ __forceinline__ unsigned xb_xcc_id() { return (unsigned)__builtin_amdgcn_s_getreg((3 << 11) | 20) & 0xFu; }
#define XB_SPIN(cond, bar) do { unsigned _sp = 0; while (cond) { __builtin_amdgcn_s_sleep(1); \
    if ((++_sp & 255u) == 0u) { if (xb_ld(&(bar)[XB_TMO])) break; if (_sp > XB_SPIN_CAP) { atomicAdd(&(bar)[XB_TMO], 1u); break; } } } } while (0)
struct XcdBarrier { unsigned* bar; unsigned x; volatile LAS unsigned* st; };
__device__ __forceinline__ XcdBarrier xcd_barrier_post(unsigned* bar, volatile LAS unsigned* st) {
    XcdBarrier b; b.bar = bar; b.x = xb_xcc_id(); b.st = st;
    if (threadIdx.x == 0) (void)xb_add(&bar[XB_XCNT(b.x)], 1u);
    return b;
}
__device__ __forceinline__ void xcd_barrier_complete(unsigned* bar, unsigned x, unsigned& nloc, unsigned& nx) {
    const unsigned G = gridDim.x * gridDim.y * gridDim.z;
    unsigned sum, cnt, mine, sp = 0u;
    for (;;) {
        sum = 0u; cnt = 0u; mine = 0u;
#pragma unroll
        for (unsigned j = 0; j < 16; ++j) { const unsigned c = xb_ld(&bar[XB_XCNT(j)]); sum += c; cnt += (c > 0u) ? 1u : 0u; mine = (j == x) ? c : mine; }
        if (sum == G) break;
        __builtin_amdgcn_s_sleep(1);
        if ((++sp & 255u) == 0u) { if (xb_ld(&bar[XB_TMO])) break; if (sp > XB_SPIN_CAP) { atomicAdd(&bar[XB_TMO], 1u); break; } }
    }
    nloc = mine > 0u ? mine : 1u; nx = cnt > 0u ? cnt : 1u;
}
__device__ __forceinline__ void xcd_barrier(const XcdBarrier& b, bool leader) {
    asm volatile("s_waitcnt vmcnt(0)" ::: "memory");
    __syncthreads();
    if (leader) {
        unsigned* bar = b.bar;
        __builtin_amdgcn_s_waitcnt(0);
        unsigned nloc = b.st[0], nx = b.st[1];
        if (nloc == 0u) { xcd_barrier_complete(bar, b.x, nloc, nx); b.st[0] = nloc; b.st[1] = nx; }
        const unsigned old = xb_add(&bar[XB_XSUB(b.x)], 1u);
        const unsigned gen = old / nloc;
        if (old + 1u == (gen + 1u) * nloc) {
            __builtin_amdgcn_fence(__ATOMIC_RELEASE, "agent");
            asm volatile("s_waitcnt vmcnt(0)" ::: "memory");
            const unsigned og = xb_add(&bar[XB_TOP], 1u);
            const unsigned tg = og / nx;
            if (og + 1u == (tg + 1u) * nx) xb_add(&bar[XB_TOPGEN], 1u);
            else XB_SPIN(xb_ld(&bar[XB_TOPGEN]) == tg, bar);
            __builtin_amdgcn_fence(__ATOMIC_ACQUIRE, "agent");
            xb_add(&bar[XB_XGEN(b.x)], 1u);
            asm volatile("s_waitcnt vmcnt(0)" ::: "memory");
        } else {
            XB_SPIN(xb_ld(&bar[XB_XGEN(b.x)]) == gen, bar);
            __builtin_amdgcn_fence(__ATOMIC_ACQUIRE, "agent");
            asm volatile("s_waitcnt vmcnt(0)" ::: "memory");
        }
    }
    __syncthreads();
}

constexpr int NPH = 22;
__global__ void __launch_bounds__(512, 2) yoco_fwd(Params p) {
    extern __shared__ __attribute__((aligned(16))) unsigned char shm[];
    LAS unsigned char* lds = (LAS unsigned char*)shm;
    cg::grid_group grid = cg::this_grid();
    if (p.never) grid.sync();
    volatile LAS unsigned* xst = (volatile LAS unsigned*)(lds + LDS_BYTES - 16);
    if (threadIdx.x < 4) xst[threadIdx.x] = 0u;
    __syncthreads();
    const XcdBarrier xbar = xcd_barrier_post((unsigned*)p.ws, xst);
    const int wv = __builtin_amdgcn_readfirstlane((int)(threadIdx.x >> 6));
#define GSYNC() xcd_barrier(xbar, opaque_tid(wv) == 0)
    const int G = gridDim.x;
#pragma unroll 1
    for (int ph = 0; ph < NPH; ++ph) {
        const int bid = opaque_bid();
        unsigned char* ws = p.ws;
        const float* MOD = (const float*)(ws + WS_MOD);
        int kind, l;
        if (ph == 0) { kind = 0; l = 0; }
        else if (ph <= 10) { l = (ph - 1) / 5; kind = 1 + (ph - 1) % 5; }
        else if (ph == 11) { kind = 6; l = 0; }
        else if (ph == 12) { kind = 7; l = 0; }
        else if (ph == 17) { kind = 11; l = 1; }
        else { l = ph >= 18 ? 1 : 0; const int q = (ph - (l ? 18 : 13)); kind = q == 0 ? 8 : q == 1 ? 9 : q == 2 ? 10 : 5; }
        const bool layerB = ph > 10;
        const int kind0 = kind; const int nrep = ((PH_REP >> kind0) & 1) ? (kind0 == 9 ? 3 : 2) : 1;
#pragma unroll 1
        for (int rep = 0; rep < nrep; ++rep) {
        kind = (kind0 == 9 && rep == 1) ? 8 : kind0; if (rep > 0 && kind0 == 9) GSYNC();
        if (kind == 0) { if (PH_MASK & 1) phase0(wv, p, lds); }
        else if (kind == 1) { if (PH_MASK & 2) norm_phase(wv, l == 0 ? p.in[0] : p.out, p.in[4] + l * 1024, MOD + l * 3072, (bf16_t*)(ws + WS_H)); }
        else if (kind == 2) { if (PH_MASK & 4) {
            pg8::Gemm g{(const bf16_t*)(ws + WS_WVA) + (size_t)l * 2048 * 1024, (const bf16_t*)(ws + WS_H), 1024, 1024, 1024, 0, 0}; pg8::StaticOrder S; S.init(2048, T, G, bid);
            EpiVg E{(bf16_t*)(ws + WS_BUF1), (float*)(ws + WS_PART)}; pg8::gemm_phase<EpiVg>(wv, lds, g, S, E); } }
        else if (kind == 3) { if (PH_MASK & 8) mix_phase(wv, p, lds, l); }
        else if (kind == 4) { if (PH_MASK & 16) {
            pg8::Gemm g{(const bf16_t*)(ws + WS_H), (const bf16_t*)(ws + WS_WUZ) + (size_t)l * 4096 * 1024, 1024, 1024, 1024, 0, 0}; pg8::StaticOrder S; S.init(T, 4096, G, bid);
            EpiUZ E{(const bf16_t*)(ws + WS_BUF2), (bf16_t*)(ws + WS_BUF1)}; pg8::gemm_phase<EpiUZ>(wv, lds, g, S, E); } }
        else if (kind == 5) { if (PH_MASK & 32) {
            pg8::Gemm g; g.dilA = 0; g.dilB = 0; const float* base; const float* gate;
            if (!layerB) { g.A = (const bf16_t*)(ws + WS_BUF1); g.Bt = (const bf16_t*)(ws + WS_WOA) + (size_t)l * 1024 * 2048; g.lda = 2048; g.ldb = 2048; g.K = 2048; base = (l == 0) ? p.in[0] : p.out; gate = MOD + l * 3072 + 2048; }
            else { g.A = (const bf16_t*)(ws + WS_HB); g.Bt = (const bf16_t*)(ws + WS_WOB) + (size_t)l * 1024 * 1024; g.lda = 1024; g.ldb = 1024; g.K = 1024; base = p.out; gate = MOD + 8192 + l * 3072 + 2048; }
            pg8::StaticOrder S; S.init(T, 1024, G, bid);
            EpiOut E{base, p.out, gate}; pg8::gemm_phase<EpiOut>(wv, lds, g, S, E); } }
        else if (kind == 6) { if (PH_MASK & 2) { norm_phase(wv, p.out, p.in[12], MOD + 6144, (bf16_t*)(ws + WS_ZS), p.in[17], MOD + 8192, (bf16_t*)(ws + WS_HB)); } }
        else if (kind == 11) { if (PH_MASK & 2) norm_phase(wv, p.out, p.in[17] + 1024, MOD + 8192 + 3072, (bf16_t*)(ws + WS_HB)); }
        else if (kind == 7 || kind == 8) { if (PH_MASK & 64) {
            const int ncall = kind == 7 ? 6 : 1;
#pragma unroll 1
            for (int ci = 0; ci < ncall; ++ci) {
                pg8::Gemm g; g.K = 1024; pg8::StaticOrder S; EpiBf16 E; E.ACT = 0; E.O2 = nullptr;
                if (kind == 7) {
                    const int gq = ci % 3, d = 1 << (2 * gq); const bf16_t* HKV = (const bf16_t*)(ws + WS_ZS); const bf16_t* WKV = (const bf16_t*)(ws + WS_WKV);
                    if (ci < 3) { g.A = HKV; g.Bt = WKV + (size_t)gq * 256 * 1024; g.lda = d * 1024; g.ldb = 1024; g.dilA = d; g.dilB = 0; S.init(T, 256, G, (bid + (ci & 1) * 128) % G);
                        E.O = (bf16_t*)(ws + WS_KD) + (size_t)gq * T * 256; E.ldc = 256; E.ACT = 4; }
                    else { g.A = WKV + (size_t)(768 + gq * 256) * 1024; g.Bt = HKV; g.lda = 1024; g.ldb = d * 1024; g.dilA = 0; g.dilB = d; S.init(256, T, G, (bid + (ci & 1) * 128) % G);
                        E.O = (bf16_t*)(ws + WS_VT) + (size_t)gq * 256 * T; E.ldc = (size_t)T; E.ACT = 3; }
                } else {
                    g.A = (const bf16_t*)(ws + WS_HB); g.Bt = (const bf16_t*)(ws + WS_WQB) + (size_t)l * 4096 * 1024; g.lda = 1024; g.ldb = 1024; g.dilA = 0; g.dilB = 0; E.ldc = 1024;
                    E.O = (bf16_t*)(ws + WS_QO); E.O2 = (bf16_t*)(ws + WS_ZS); E.ACT = 6;
                    S.init(T, 4096, G, bid);
                }
                pg8::gemm_phase<EpiBf16>(wv, lds, g, S, E);
            } } }
        else if (kind == 9 || kind == 10) { if (PH_MASK & 256) attn_phase(wv, p, lds, l, kind == 10 ? 1 : 0); }
        }
        if (ph + 1 < NPH) GSYNC();
    }
}

extern "C" void kernel_launch(void* const* d_in, const int* in_sizes, int n_in, void* d_out, int out_size, void* d_ws, size_t ws_size, hipStream_t stream) {
    static int grid = 0;
    if (grid == 0) {
        if (n_in != 21 || ws_size < WS_END) { fprintf(stderr, "kernel_launch: unexpected n_in %d / ws_size %zu (need %zu)\n", n_in, ws_size, (size_t)WS_END); grid = -1; return; }
        int dev = 0, cus = 0, per_cu = 0;
        hipGetDevice(&dev); hipDeviceGetAttribute(&cus, hipDeviceAttributeMultiprocessorCount, dev);
        if (hipFuncSetAttribute((const void*)yoco_fwd, hipFuncAttributeMaxDynamicSharedMemorySize, LDS_BYTES) != hipSuccess) { fprintf(stderr, "kernel_launch: hipFuncSetAttribute failed\n"); grid = -1; return; }
        hipOccupancyMaxActiveBlocksPerMultiprocessor(&per_cu, (const void*)yoco_fwd, 512, LDS_BYTES);
        if (per_cu < 1) { fprintf(stderr, "kernel_launch: occupancy query says %d blocks per CU\n", per_cu); per_cu = 1; }
        (void)hipGetLastError();
        grid = cus;
    }
    if (grid < 0) return;
    Params p{};
    for (int i = 0; i < 21; ++i) p.in[i] = (const float*)d_in[i];
    p.out = (float*)d_out; p.ws = (unsigned char*)d_ws; p.never = 0; p.pad = 0;
    if (hipMemsetAsync(d_ws, 0, XCD_BAR_WORDS * 4, stream) != hipSuccess) { fprintf(stderr, "kernel_launch: memset failed\n"); return; }
    void* args[] = {&p};
    hipError_t e = hipLaunchCooperativeKernel((const void*)yoco_fwd, dim3(grid), dim3(512), args, LDS_BYTES, stream);
    if (e != hipSuccess) fprintf(stderr, "cooperative launch failed: %s (grid %d)\n", hipGetErrorString(e), grid);
}
```

```cpp
#include <hip/hip_runtime.h>
#include <hip/hip_cooperative_groups.h>
#include <cstdio>
namespace cg = cooperative_groups;

#define LAS __attribute__((address_space(3)))
typedef unsigned short bf16_t;
typedef short bf16x8 __attribute__((ext_vector_type(8)));
typedef float f32x4 __attribute__((ext_vector_type(4)));
typedef unsigned u32x4 __attribute__((ext_vector_type(4)));
typedef unsigned u32x2 __attribute__((ext_vector_type(2)));

constexpr int T = 32768, DM = 1024, SEQ = 4096;
constexpr int MODW = 14336;
constexpr float EPS = 1e-6f;
constexpr float LOG2E = 1.4426950408889634f;
constexpr float LN2 = 0.6931471805599453f;

constexpr size_t MiB = 1024 * 1024;
constexpr size_t WS_MOD  = 64 * 1024;
constexpr size_t WS_PART = 1 * MiB;
constexpr size_t WS_LSE  = 3 * MiB;
constexpr size_t WS_WVA  = 6 * MiB;
constexpr size_t WS_WUZ  = WS_WVA + 8 * MiB;
constexpr size_t WS_WOA  = WS_WUZ + 16 * MiB;
constexpr size_t WS_WKV  = WS_WOA + 8 * MiB;
constexpr size_t WS_WQB  = WS_WKV + 3 * MiB;
constexpr size_t WS_WOB  = WS_WQB + 16 * MiB;
constexpr size_t WS_BIG  = WS_WOB + 4 * MiB;
constexpr size_t WS_H    = WS_BIG;
constexpr size_t WS_BUF1 = WS_H + 64 * MiB;
constexpr size_t WS_BUF2 = WS_BUF1 + 128 * MiB;
constexpr size_t WS_QO   = WS_BIG;
constexpr size_t WS_KD   = WS_QO + 192 * MiB;
constexpr size_t WS_VT   = WS_KD + 48 * MiB;
constexpr size_t WS_ZS   = WS_VT + 48 * MiB;
constexpr size_t WS_HB   = WS_ZS + 64 * MiB;
constexpr size_t WS_END  = WS_HB + 64 * MiB;
constexpr int LDS_BYTES = 137216;

#ifndef PH_REP
#define PH_REP 0
#endif
#ifndef PH_MASK
#define PH_MASK 0xFFFF
#endif
struct Params { const float* in[21]; float* out; unsigned char* ws; int never; int pad; };

__device__ __forceinline__ unsigned cvt_pk_bf16(float lo, float hi) { unsigned r; asm volatile("v_cvt_pk_bf16_f32 %0, %1, %2" : "=v"(r) : "v"(lo), "v"(hi)); return r; }
__device__ __forceinline__ float bf_lo(unsigned w) { return __uint_as_float(w << 16); }
__device__ __forceinline__ float bf_hi(unsigned w) { return __uint_as_float(w & 0xffff0000u); }
__device__ __forceinline__ int opaque_tid(int wv) { int t; asm volatile("v_mbcnt_lo_u32_b32 %0, -1, 0\n\tv_mbcnt_hi_u32_b32 %0, -1, %0" : "=v"(t)); return (wv << 6) | t; }
__device__ __forceinline__ int opaque_bid() { int t = blockIdx.x; asm volatile("" : "+s"(t)); return t; }
#define dpp_f(x, ctrl) __builtin_bit_cast(float, __builtin_amdgcn_update_dpp(0, __builtin_bit_cast(int, (x)), (ctrl), 0xF, 0xF, true))
__device__ __forceinline__ float shx(float v, int mask, int lane) { return __builtin_bit_cast(float, __builtin_amdgcn_ds_bpermute((lane ^ mask) << 2, __builtin_bit_cast(int, v))); }
__device__ __forceinline__ float ex2(float x) { return __builtin_amdgcn_exp2f(x); }
__device__ __forceinline__ float silu_f(float x) { return x * __builtin_amdgcn_rcpf(1.0f + ex2(-LOG2E * x)); }
__device__ __forceinline__ float gelu_f(float x) {
    const float y = 0.7978845608028654f * (x + 0.044715f * x * x * x);
    return x * __builtin_amdgcn_rcpf(1.0f + ex2(-2.0f * LOG2E * y));
}

typedef float f32x2 __attribute__((ext_vector_type(2)));
constexpr float GC1 = -2.0f * 1.4426950408889634f * 0.7978845608028654f, GC3 = GC1 * 0.044715f;
__device__ __forceinline__ f32x2 gelu_arg2(f32x2 x) { return x * ((x * x) * GC3 + GC1); }
__device__ __forceinline__ f32x2 ex2_2(f32x2 a) { f32x2 r; r.x = __builtin_amdgcn_exp2f(a.x); r.y = __builtin_amdgcn_exp2f(a.y); return r; }
__device__ __forceinline__ f32x2 rcp_2(f32x2 a) { f32x2 r; r.x = __builtin_amdgcn_rcpf(a.x); r.y = __builtin_amdgcn_rcpf(a.y); return r; }
__device__ __forceinline__ f32x2 gelu_2(f32x2 x) { return x * rcp_2(ex2_2(gelu_arg2(x)) + 1.0f); }
__device__ __forceinline__ f32x2 gate_2(f32x2 u, f32x2 z, f32x2 m) {
    const f32x2 d = (ex2_2(gelu_arg2(u)) + 1.0f) * (ex2_2(z * (-LOG2E)) + 1.0f);
    return ((u * z) * m) * rcp_2(d);
}

namespace pg8 {
constexpr int BM = 256, BK = 64, HALF = 128, HTB = HALF * BK * 2, STAGE_BYTES = 8 * HTB, NXCD = 8, WGM = 8;
__device__ __forceinline__ int lds_byte(int r, int c) { const int st = (r >> 4) * 2 + (c >> 5), rr = r & 15, cc = c & 31, ob = rr * 64 + cc * 2; return st * 1024 + (ob ^ (((ob >> 9) & 1) << 5)); }
__device__ __forceinline__ void stage_rc(int b, int& R, int& C) { const int st = b / 1024, sb = b % 1024, swz = sb ^ (((sb >> 9) & 1) << 5); R = (st >> 1) * 16 + swz / 64; C = (st & 1) * 32 + (swz % 64) / 2; }
__device__ __forceinline__ int perm32(int rho) { const int n = rho >> 4, i = rho & 15; return 8 * (i >> 2) + 4 * n + (i & 3); }

struct Unit { int pm, pn; };
struct Gemm { const bf16_t* A; const bf16_t* Bt; int lda, ldb, K, dilA, dilB; };
__device__ __forceinline__ const char* panel_base(const bf16_t* base, int p, int ld, int dil, int K) {
    if (dil == 0) return (const char*)base + (size_t)p * 256 * (size_t)ld * 2;
    const int b = p >> 4, pp = p & 15, per = 16 / dil, r = pp / per, q0 = (pp % per) * 256;
    const size_t tok = (size_t)b * SEQ + (size_t)q0 * dil + r;
    return (const char*)base + tok * (size_t)K * 2;
}

struct StaticOrder {
    int nM, nN, nwg, G, c;
    __device__ void init(int M, int N, int G_, int c_) { nM = M / BM; nN = N / BM; nwg = nM * nN; G = G_; c = c_; }
    __device__ bool next(int i, Unit& u) const {
        const long L = (long)i * G + c; if (L >= nwg) return false;
        int wgid = (int)L; { const int q = nwg / NXCD, r = nwg % NXCD, xcd = wgid % NXCD, off = wgid / NXCD; wgid = (xcd < r ? xcd * (q + 1) : r * (q + 1) + (xcd - r) * q) + off; }
        const int nig = WGM * nN, gid = wgid / nig, fm = gid * WGM, gsz = (nM - fm) < WGM ? (nM - fm) : WGM;
        u.pm = fm + ((wgid % nig) % gsz); u.pn = (wgid % nig) / gsz; return true;
    }
};

template <class Epi>
__device__ __forceinline__ void gemm_phase(int wv, LAS unsigned char* lds, const Gemm g, const StaticOrder& S, const Epi& E) {
    const int tid = opaque_tid(wv), wid = __builtin_amdgcn_readfirstlane(tid >> 6), lane = tid & 63, wr = wid >> 2, wc = wid & 3, fr = lane & 15, fq = lane >> 4;
    const int K = g.K, nt = K / BK;
    unsigned voffA[2], voffB[2];
#pragma unroll
    for (int i = 0; i < 2; ++i) { int R, C; stage_rc(tid * 16 + i * 8192, R, C); const int Rb = Epi::PERM ? ((R & ~31) + perm32(R & 31)) : R;
        voffA[i] = (unsigned)(R * g.lda + C) * 2u; voffB[i] = (unsigned)(Rb * g.ldb + C) * 2u; }
    const size_t kstep = (size_t)(BK * 2);
    const size_t hstepA = (size_t)HALF * g.lda * 2, hstepB = (size_t)HALF * g.ldb * 2;
    const unsigned ldsw = (unsigned)wid * 1024u;
    const int aoff = lds_byte(wr * 64 + fr, fq * 8), boff = lds_byte(wc * 32 + fr, fq * 8);
#define PG8_SA(b, h) (((b) * 2 + (h)) * HTB)
#define PG8_SB(b, h) ((4 + (b) * 2 + (h)) * HTB)
#define PG8_STAGE(bufoff, gbase, voff) do { _Pragma("unroll") for (int _i = 0; _i < 2; ++_i) \
        __builtin_amdgcn_global_load_lds((const unsigned*)((const char*)(gbase) + (voff)[_i]), (LAS unsigned*)(lds + (bufoff) + ldsw + _i * 8192), 16, 0, 0); } while (0)
#define PG8_LDA(dst, b, h) do { _Pragma("unroll") for (int m = 0; m < 4; ++m) _Pragma("unroll") for (int k = 0; k < 2; ++k) dst[m][k] = *(const LAS bf16x8*)(lds + PG8_SA(b, h) + aoff + m * 2048 + k * 1024); } while (0)
#define PG8_LDB(dst, b, h) do { _Pragma("unroll") for (int n = 0; n < 2; ++n) _Pragma("unroll") for (int k = 0; k < 2; ++k) dst[n][k] = *(const LAS bf16x8*)(lds + PG8_SB(b, h) + boff + n * 2048 + k * 1024); } while (0)
#define PG8_MMA(ai, bj, At, Bt) do { __builtin_amdgcn_s_setprio(1); _Pragma("unroll") for (int m = 0; m < 4; ++m) _Pragma("unroll") for (int n = 0; n < 2; ++n) _Pragma("unroll") for (int k = 0; k < 2; ++k) \
        acc[ai][bj][m][n] = __builtin_amdgcn_mfma_f32_16x16x32_bf16(Bt[n][k], At[m][k], acc[ai][bj][m][n], 0, 0, 0); __builtin_amdgcn_s_setprio(0); } while (0)
#define PG8_WAIT_V(n) asm volatile("s_waitcnt vmcnt(" #n ")" ::: "memory")
#define PG8_WAIT_L(n) asm volatile("s_waitcnt lgkmcnt(" #n ")" ::: "memory")
#define PG8_BAR __builtin_amdgcn_s_barrier()
#define PG8_SCHED __builtin_amdgcn_sched_barrier(0)
    Unit cur, nxt; int ui = 0;
    if (!S.next(0, cur)) return;
    f32x4 acc[2][2][4][2];
#pragma unroll
    for (int a = 0; a < 2; ++a)
#pragma unroll
        for (int b = 0; b < 2; ++b)
#pragma unroll
            for (int m = 0; m < 4; ++m)
#pragma unroll
                for (int n = 0; n < 2; ++n) acc[a][b][m][n] = (f32x4){0.f, 0.f, 0.f, 0.f};
    bf16x8 At[4][2], B0[2][2], B1[2][2];
    const char* cA = panel_base(g.A, cur.pm, g.lda, g.dilA, K); const char* cB = panel_base(g.Bt, cur.pn, g.ldb, g.dilB, K);
    PG8_STAGE(PG8_SB(0, 0), cB, voffB); PG8_STAGE(PG8_SA(0, 0), cA, voffA); PG8_STAGE(PG8_SB(0, 1), cB + hstepB, voffB); PG8_STAGE(PG8_SA(0, 1), cA + hstepA, voffA);
    if (wr == 1) PG8_BAR;
    PG8_WAIT_V(4); PG8_BAR;
    PG8_STAGE(PG8_SB(1, 0), cB + kstep, voffB); PG8_STAGE(PG8_SA(1, 0), cA + kstep, voffA); PG8_STAGE(PG8_SB(1, 1), cB + hstepB + kstep, voffB);
    PG8_WAIT_V(6); PG8_BAR;
    for (;;) {
        const bool has_next = S.next(ui + 1, nxt);
        const char* nA = has_next ? panel_base(g.A, nxt.pm, g.lda, g.dilA, K) : cA; const char* nB = has_next ? panel_base(g.Bt, nxt.pn, g.ldb, g.dilB, K) : cB;
        for (int t = 0; t < nt; t += 2) {
            const bool last = (t == nt - 2);
            const char* a1 = cA + (size_t)(t + 1) * kstep;
            const char* a2 = last ? nA : cA + (size_t)(t + 2) * kstep; const char* b2 = last ? nB : cB + (size_t)(t + 2) * kstep;
            const char* a3 = a2 + kstep; const char* b3 = b2 + kstep;
            PG8_LDB(B0, 0, 0); PG8_SCHED; PG8_LDA(At, 0, 0); PG8_STAGE(PG8_SA(1, 1), a1 + hstepA, voffA);
            PG8_WAIT_L(8); PG8_BAR; PG8_WAIT_L(0); PG8_MMA(0, 0, At, B0); PG8_BAR; PG8_SCHED;
            PG8_LDB(B1, 0, 1); PG8_STAGE(PG8_SB(0, 0), b2, voffB);
            PG8_BAR; PG8_WAIT_L(0); PG8_MMA(0, 1, At, B1); PG8_BAR;
            PG8_LDA(At, 0, 1); PG8_STAGE(PG8_SA(0, 0), a2, voffA);
            PG8_BAR; PG8_WAIT_L(0); PG8_MMA(1, 0, At, B0); PG8_BAR; PG8_SCHED;
            PG8_STAGE(PG8_SB(0, 1), b2 + hstepB, voffB);
            PG8_WAIT_V(6); PG8_BAR; PG8_MMA(1, 1, At, B1); PG8_BAR;
            PG8_LDB(B0, 1, 0); PG8_SCHED; PG8_LDA(At, 1, 0); PG8_STAGE(PG8_SA(0, 1), a2 + hstepA, voffA);
            PG8_WAIT_L(8); PG8_BAR; PG8_WAIT_L(0); PG8_MMA(0, 0, At, B0); PG8_BAR; PG8_SCHED;
            PG8_LDB(B1, 1, 1); PG8_STAGE(PG8_SB(1, 0), b3, voffB);
            PG8_BAR; PG8_WAIT_L(0); PG8_MMA(0, 1, At, B1); PG8_BAR;
            PG8_LDA(At, 1, 1); PG8_STAGE(PG8_SA(1, 0), a3, voffA);
            PG8_BAR; PG8_WAIT_L(0); PG8_MMA(1, 0, At, B0); PG8_BAR; PG8_SCHED;
            PG8_STAGE(PG8_SB(1, 1), b3 + hstepB, voffB);
            PG8_WAIT_V(6); PG8_BAR; PG8_MMA(1, 1, At, B1); PG8_BAR;
        }
        E(acc, cur, wr, wc, fr, fq);
        if (!has_next) break;
#pragma unroll
        for (int a = 0; a < 2; ++a)
#pragma unroll
            for (int b = 0; b < 2; ++b)
#pragma unroll
                for (int m = 0; m < 4; ++m)
#pragma unroll
                    for (int n = 0; n < 2; ++n) acc[a][b][m][n] = (f32x4){0.f, 0.f, 0.f, 0.f};
        cur = nxt; cA = nA; cB = nB; ++ui;
    }
    PG8_WAIT_V(0);
    if (wr == 0) PG8_BAR;
    PG8_BAR;
#undef PG8_SA
#undef PG8_SB
#undef PG8_STAGE
#undef PG8_LDA
#undef PG8_LDB
#undef PG8_MMA
#undef PG8_WAIT_V
#undef PG8_WAIT_L
#undef PG8_BAR
#undef PG8_SCHED
}
}

struct EpiBf16 {
    static constexpr bool PERM = true;
    __device__ __forceinline__ void touch(const pg8::Unit&, LAS unsigned*, int) const {}
    bf16_t* O; bf16_t* O2; size_t ldc; int ACT;
    __device__ __forceinline__ void operator()(const f32x4 (&acc)[2][2][4][2], const pg8::Unit& u, int wr, int wc, int fr, int fq) const {
        const int row0 = u.pm * 256 + wr * 64 + fr, col0 = u.pn * 256 + wc * 32 + 8 * fq;
        if (ACT == 6) {
            const int pn = u.pn;
            if (pn < 12) { const int gq = pn >> 2, sh = 2 * gq; bf16_t* Og = O + (size_t)gq * T * 1024;
#pragma unroll
                for (int ai = 0; ai < 2; ++ai)
#pragma unroll
                    for (int m = 0; m < 4; ++m) { const int r = row0 + ai * 128 + m * 16, b = r >> 12, sq = r & 4095, pos = ((sq & ((1 << sh) - 1)) << (12 - sh)) + (sq >> sh);
                        bf16_t* rowp = Og + ((size_t)(b * 8 + (pn & 3) * 2) * 4096 + pos) * 128 + wc * 32 + 8 * fq;
#pragma unroll
                        for (int bj = 0; bj < 2; ++bj) { const f32x4 v0 = acc[ai][bj][m][0], v1 = acc[ai][bj][m][1];
                            u32x4 w; w.x = cvt_pk_bf16(v0[0], v0[1]); w.y = cvt_pk_bf16(v0[2], v0[3]); w.z = cvt_pk_bf16(v1[0], v1[1]); w.w = cvt_pk_bf16(v1[2], v1[3]);
                            *(u32x4*)(rowp + (size_t)bj * 4096 * 128) = w; } }
            } else { bf16_t* Oz = O2 + (pn - 12) * 256 + wc * 32 + 8 * fq;
#pragma unroll
                for (int ai = 0; ai < 2; ++ai)
#pragma unroll
                    for (int m = 0; m < 4; ++m) { bf16_t* rowp = Oz + (size_t)(row0 + ai * 128 + m * 16) * 1024;
#pragma unroll
                        for (int bj = 0; bj < 2; ++bj) { f32x4 v0 = acc[ai][bj][m][0], v1 = acc[ai][bj][m][1];
#pragma unroll
                            for (int j = 0; j < 4; ++j) { v0[j] = silu_f(v0[j]); v1[j] = silu_f(v1[j]); }
                            u32x4 w; w.x = cvt_pk_bf16(v0[0], v0[1]); w.y = cvt_pk_bf16(v0[2], v0[3]); w.z = cvt_pk_bf16(v1[0], v1[1]); w.w = cvt_pk_bf16(v1[2], v1[3]);
                            *(u32x4*)(rowp + bj * 128) = w; } }
            }
            return;
        }
        const bool vt = (ACT == 3), kh = (ACT == 4), qh = (ACT == 5);
        const size_t bjs = vt ? (size_t)16384 : (kh || qh) ? (size_t)4096 * 128 : (size_t)128;
#pragma unroll
        for (int ai = 0; ai < 2; ++ai)
#pragma unroll
            for (int m = 0; m < 4; ++m) { bf16_t* rowp = vt ? O + ((size_t)(((u.pn >> 4) * 2 + ai) * 32 + (u.pn & 15) * 2) * 128 + (wr * 64 + m * 16 + fr)) * 128 + wc * 32 + 8 * fq
                                                      : kh ? O + ((size_t)((u.pm >> 4) * 2) * 4096 + ((row0 + ai * 128 + m * 16) & 4095)) * 128 + wc * 32 + 8 * fq
                                                      : qh ? O + ((size_t)((u.pm >> 4) * 8 + u.pn * 2) * 4096 + ((row0 + ai * 128 + m * 16) & 4095)) * 128 + wc * 32 + 8 * fq
                                                           : O + (size_t)(row0 + ai * 128 + m * 16) * ldc + col0;
#pragma unroll
                for (int bj = 0; bj < 2; ++bj) { f32x4 v0 = acc[ai][bj][m][0], v1 = acc[ai][bj][m][1];
                    if (ACT == 2) {
#pragma unroll
                        for (int j = 0; j < 4; ++j) { v0[j] = silu_f(v0[j]); v1[j] = silu_f(v1[j]); } }
                    u32x4 w; w.x = cvt_pk_bf16(v0[0], v0[1]); w.y = cvt_pk_bf16(v0[2], v0[3]); w.z = cvt_pk_bf16(v1[0], v1[1]); w.w = cvt_pk_bf16(v1[2], v1[3]);
                    *(u32x4*)(rowp + bj * bjs) = w; } }
    }
};
struct EpiVg {
    static constexpr bool PERM = true;
    __device__ __forceinline__ void touch(const pg8::Unit&, LAS unsigned*, int) const {}
    bf16_t* O; float* part;
    __device__ __forceinline__ void operator()(const f32x4 (&acc)[2][2][4][2], const pg8::Unit& u, int wr, int wc, int fr, int fq) const {
        const int row0 = u.pm * 256 + wr * 64 + fr, col0 = u.pn * 256 + wc * 32 + 8 * fq;
        float cs[2][2][4];
#pragma unroll
        for (int bj = 0; bj < 2; ++bj)
#pragma unroll
            for (int n = 0; n < 2; ++n)
#pragma unroll
                for (int j = 0; j < 4; ++j) cs[bj][n][j] = 0.f;
#pragma unroll
        for (int ai = 0; ai < 2; ++ai)
#pragma unroll
            for (int m = 0; m < 4; ++m) { bf16_t* rowp = O + ((size_t)(u.pn * 2) * 8 + u.pm) * 32768 + (wr * 64 + fr + ai * 128 + m * 16) * 128 + wc * 32 + 8 * fq;
#pragma unroll
                for (int bj = 0; bj < 2; ++bj) { f32x4 v0 = acc[ai][bj][m][0], v1 = acc[ai][bj][m][1];
#pragma unroll
                    for (int j = 0; j < 4; j += 2) { const f32x2 a = gelu_2((f32x2){v0[j], v0[j + 1]}), b = gelu_2((f32x2){v1[j], v1[j + 1]});
                        v0[j] = a.x; v0[j + 1] = a.y; v1[j] = b.x; v1[j + 1] = b.y;
                        cs[bj][0][j] += a.x * a.x; cs[bj][0][j + 1] += a.y * a.y; cs[bj][1][j] += b.x * b.x; cs[bj][1][j + 1] += b.y * b.y; }
                    u32x4 w; w.x = cvt_pk_bf16(v0[0], v0[1]); w.y = cvt_pk_bf16(v0[2], v0[3]); w.z = cvt_pk_bf16(v1[0], v1[1]); w.w = cvt_pk_bf16(v1[2], v1[3]);
                    *(u32x4*)(rowp + (size_t)bj * 8 * 32768) = w; } }
#pragma unroll
        for (int bj = 0; bj < 2; ++bj)
#pragma unroll
            for (int n = 0; n < 2; ++n)
#pragma unroll
                for (int j = 0; j < 4; ++j) { float s = cs[bj][n][j]; s += dpp_f(s, 0xB1); s += dpp_f(s, 0x4E); s += dpp_f(s, 0x141); s += dpp_f(s, 0x140);
                    if (fr == 0) part[(size_t)(col0 + bj * 128 + 4 * n + j) * 16 + u.pm * 2 + wr] = s; }
    }
};
struct EpiUZ {
    static constexpr bool PERM = true;
    const bf16_t* mixed; bf16_t* Y;
    __device__ __forceinline__ void touch(const pg8::Unit& u, LAS unsigned* dummy, int tid) const {
        __builtin_amdgcn_global_load_lds((const unsigned*)((const char*)(mixed + (size_t)(u.pm * 256) * 2048 + u.pn * 128) + (unsigned)((tid >> 1) * 4096 + (tid & 1) * 128)), dummy, 4, 0, 0); }
    __device__ __forceinline__ void operator()(const f32x4 (&acc)[2][2][4][2], const pg8::Unit& u, int wr, int wc, int fr, int fq) const {
        const int row0 = u.pm * 256 + wr * 64 + fr, col0 = u.pn * 128 + wc * 32 + 8 * fq;
        u32x4 mxa[2][4];
#pragma unroll
        for (int ai = 0; ai < 2; ++ai)
#pragma unroll
            for (int m = 0; m < 4; ++m) mxa[ai][m] = *(const u32x4*)(mixed + (size_t)(row0 + ai * 128 + m * 16) * 2048 + col0);
#pragma unroll
        for (int ai = 0; ai < 2; ++ai)
#pragma unroll
            for (int m = 0; m < 4; ++m) { const size_t off = (size_t)(row0 + ai * 128 + m * 16) * 2048 + col0;
                const u32x4 mx = mxa[ai][m];
                const f32x4 u0 = acc[ai][0][m][0], u1 = acc[ai][0][m][1], z0 = acc[ai][1][m][0], z1 = acc[ai][1][m][1];
                const f32x2 y01 = gate_2((f32x2){u0[0], u0[1]}, (f32x2){z0[0], z0[1]}, (f32x2){bf_lo(mx.x), bf_hi(mx.x)});
                const f32x2 y23 = gate_2((f32x2){u0[2], u0[3]}, (f32x2){z0[2], z0[3]}, (f32x2){bf_lo(mx.y), bf_hi(mx.y)});
                const f32x2 y45 = gate_2((f32x2){u1[0], u1[1]}, (f32x2){z1[0], z1[1]}, (f32x2){bf_lo(mx.z), bf_hi(mx.z)});
                const f32x2 y67 = gate_2((f32x2){u1[2], u1[3]}, (f32x2){z1[2], z1[3]}, (f32x2){bf_lo(mx.w), bf_hi(mx.w)});
                const float y[8] = {y01.x, y01.y, y23.x, y23.y, y45.x, y45.y, y67.x, y67.y};
                u32x4 w; w.x = cvt_pk_bf16(y[0], y[1]); w.y = cvt_pk_bf16(y[2], y[3]); w.z = cvt_pk_bf16(y[4], y[5]); w.w = cvt_pk_bf16(y[6], y[7]);
                *(u32x4*)(Y + off) = w; }
    }
};
struct EpiOut {
    static constexpr bool PERM = false;
    const float* base; float* out; const float* gate;
    __device__ __forceinline__ void touch(const pg8::Unit& u, LAS unsigned* dummy, int tid) const {
        const char* b0 = (const char*)(base + (size_t)(u.pm * 256) * 1024 + u.pn * 256);
#pragma unroll
        for (int i = 0; i < 4; ++i) { const int line = tid + i * 512; __builtin_amdgcn_global_load_lds((const unsigned*)(b0 + (unsigned)((line >> 3) * 4096 + (line & 7) * 128)), dummy, 4, 0, 0); } }
    __device__ __forceinline__ void operator()(const f32x4 (&acc)[2][2][4][2], const pg8::Unit& u, int wr, int wc, int fr, int fq) const {
        const int row0 = u.pm * 256 + wr * 64 + fr, col0 = u.pn * 256 + wc * 32 + 4 * fq, b = u.pm >> 4;
        f32x4 gv[2][2];
#pragma unroll
        for (int bj = 0; bj < 2; ++bj)
#pragma unroll
            for (int n = 0; n < 2; ++n) gv[bj][n] = *(const f32x4*)(gate + (size_t)b * MODW + col0 + bj * 128 + n * 16);
#pragma unroll
        for (int ai = 0; ai < 2; ++ai) {
            f32x4 bs[4][2][2];
#pragma unroll
            for (int m = 0; m < 4; ++m) { const size_t off = (size_t)(row0 + ai * 128 + m * 16) * 1024 + col0;
#pragma unroll
                for (int bj = 0; bj < 2; ++bj)
#pragma unroll
                    for (int n = 0; n < 2; ++n) bs[m][bj][n] = *(const f32x4*)(base + off + bj * 128 + n * 16); }
#pragma unroll
            for (int m = 0; m < 4; ++m) { const size_t off = (size_t)(row0 + ai * 128 + m * 16) * 1024 + col0;
#pragma unroll
                for (int bj = 0; bj < 2; ++bj)
#pragma unroll
                    for (int n = 0; n < 2; ++n) *(f32x4*)(out + off + bj * 128 + n * 16) = bs[m][bj][n] + gv[bj][n] * acc[ai][bj][m][n]; }
        }
    }
};

__device__ void ada_unit(int wv, const Params& p, LAS float* lf, int unit) {
    const int tid = opaque_tid(wv);
    int set, cu;
    if (unit < 48) { set = 0; cu = unit; } else if (unit < 96) { set = 1; cu = unit - 48; } else if (unit < 128) { set = 2; cu = unit - 96; }
    else if (unit < 176) { set = 3; cu = unit - 128; } else { set = 4; cu = unit - 176; }
    const float* W; const float* bias; int ncol, modoff;
    if (set < 2) { W = p.in[2] + (size_t)set * 1024 * 3072; bias = p.in[3] + set * 3072; ncol = 3072; modoff = set * 3072; }
    else if (set == 2) { W = p.in[10]; bias = p.in[11]; ncol = 2048; modoff = 6144; }
    else { W = p.in[15] + (size_t)(set - 3) * 1024 * 3072; bias = p.in[16] + (set - 3) * 3072; ncol = 3072; modoff = 8192 + (set - 3) * 3072; }
    const float* c = p.in[1];
    for (int i = tid; i < 8192; i += 512) lf[i] = silu_f(c[i]);
    __syncthreads();
    const int w = tid >> 6, lane = tid & 63, col = cu * 64 + lane;
    float a0 = 0.f, a1 = 0.f, a2 = 0.f, a3 = 0.f, a4 = 0.f, a5 = 0.f, a6 = 0.f, a7 = 0.f;
#pragma unroll 16
    for (int k = w * 128; k < w * 128 + 128; ++k) {
        const float wv = W[(size_t)k * ncol + col];
        a0 += lf[k] * wv; a1 += lf[1024 + k] * wv; a2 += lf[2048 + k] * wv; a3 += lf[3072 + k] * wv;
        a4 += lf[4096 + k] * wv; a5 += lf[5120 + k] * wv; a6 += lf[6144 + k] * wv; a7 += lf[7168 + k] * wv;
    }
    LAS float* red = lf + 8192;
    red[(w * 8 + 0) * 64 + lane] = a0; red[(w * 8 + 1) * 64 + lane] = a1; red[(w * 8 + 2) * 64 + lane] = a2; red[(w * 8 + 3) * 64 + lane] = a3;
    red[(w * 8 + 4) * 64 + lane] = a4; red[(w * 8 + 5) * 64 + lane] = a5; red[(w * 8 + 6) * 64 + lane] = a6; red[(w * 8 + 7) * 64 + lane] = a7;
    __syncthreads();
    { const int b = w; float s = 0.f;
#pragma unroll
      for (int w2 = 0; w2 < 8; ++w2) s += red[(w2 * 8 + b) * 64 + lane];
      float* mod = (float*)(p.ws + WS_MOD);
      mod[(size_t)b * MODW + modoff + col] = s + bias[col]; }
    __syncthreads();
}

struct CT { const float* src; bf16_t* dst; int K, Nsrc, srccol0, row0, k0; };
__device__ __forceinline__ CT conv_decode(const Params& p, int tile) {
    int j = 0, tt = tile; CT c; c.K = 1024; int coloff = 0, map = 0;
    if (tt < 1024) { j = tt >> 9; tt &= 511; c.src = p.in[5] + (size_t)j * 1024 * 6144; c.dst = (bf16_t*)(p.ws + WS_WVA) + (size_t)j * 2048 * 1024; c.Nsrc = 6144; coloff = 2048; }
    else if (tt < 3072) { tt -= 1024; j = tt >> 10; tt &= 1023; c.src = p.in[5] + (size_t)j * 1024 * 6144; c.dst = (bf16_t*)(p.ws + WS_WUZ) + (size_t)j * 4096 * 1024; c.Nsrc = 6144; map = 1; }
    else if (tt < 4096) { tt -= 3072; j = tt >> 9; tt &= 511; c.src = p.in[9] + (size_t)j * 2048 * 1024; c.dst = (bf16_t*)(p.ws + WS_WOA) + (size_t)j * 1024 * 2048; c.Nsrc = 1024; c.K = 2048; }
    else if (tt < 4480) { tt -= 4096; c.src = p.in[13]; c.dst = (bf16_t*)(p.ws + WS_WKV); c.Nsrc = 1536; }
    else if (tt < 6528) { tt -= 4480; j = tt >> 10; tt &= 1023; c.src = p.in[18] + (size_t)j * 1024 * 4096; c.dst = (bf16_t*)(p.ws + WS_WQB) + (size_t)j * 4096 * 1024; c.Nsrc = 4096; }
    else { tt -= 6528; j = tt >> 8; tt &= 255; c.src = p.in[20] + (size_t)j * 1024 * 1024; c.dst = (bf16_t*)(p.ws + WS_WOB) + (size_t)j * 1024 * 1024; c.Nsrc = 1024; }
    const int kt = c.K / 64, rt = tt / kt, kc = tt % kt; c.row0 = rt * 64; c.k0 = kc * 64;
    c.srccol0 = c.row0 + coloff;
    if (map == 1) { const int pn = c.row0 >> 8, bj = (c.row0 >> 7) & 1, jj = c.row0 & 127; c.srccol0 = (bj ? 4096 : 0) + pn * 128 + jj; }
    return c;
}
__device__ __forceinline__ void conv_load(const CT& c, int tid, f32x4 (&v)[2]) {
    const int kk = tid >> 4, n4 = (tid & 15) * 4;
#pragma unroll
    for (int h = 0; h < 2; ++h) v[h] = *(const f32x4*)(c.src + (size_t)(c.k0 + kk + h * 32) * c.Nsrc + c.srccol0 + n4);
}
__device__ __forceinline__ void conv_store(LAS float* tl, const CT& c, int tid, const f32x4 (&v)[2]) {
    { const int kk = tid >> 4, n4 = (tid & 15) * 4;
#pragma unroll
      for (int h = 0; h < 2; ++h) { const int k = kk + h * 32; tl[(n4 + 0) * 65 + k] = v[h][0]; tl[(n4 + 1) * 65 + k] = v[h][1]; tl[(n4 + 2) * 65 + k] = v[h][2]; tl[(n4 + 3) * 65 + k] = v[h][3]; } }
    __syncthreads();
    { const int n = tid >> 3, k8 = (tid & 7) * 8; const LAS float* r = tl + n * 65 + k8;
      u32x4 w; w.x = cvt_pk_bf16(r[0], r[1]); w.y = cvt_pk_bf16(r[2], r[3]); w.z = cvt_pk_bf16(r[4], r[5]); w.w = cvt_pk_bf16(r[6], r[7]);
      *(u32x4*)(c.dst + (size_t)(c.row0 + n) * c.K + c.k0 + k8) = w; }
    __syncthreads();
}

__device__ void phase0(int wv, const Params& p, LAS unsigned char* lds) {
    LAS float* lf = (LAS float*)lds;
    const int bx = opaque_bid(), tid = opaque_tid(wv);
    f32x4 vcur[2], vnxt[2];
    CT cur = conv_decode(p, bx);
    conv_load(cur, tid, vcur);
    if (bx < 224) ada_unit(wv, p, lf, bx);
    for (int tile = bx; tile < 7040; tile += gridDim.x) {
        const int nt = tile + gridDim.x; CT nxt = cur;
        if (nt < 7040) { nxt = conv_decode(p, nt); conv_load(nxt, tid, vnxt); }
        conv_store(lf, cur, tid, vcur);
        cur = nxt; vcur[0] = vnxt[0]; vcur[1] = vnxt[1];
    }
}

__device__ void norm_phase(int wv, const float* x, const float* g, const float* mod  , bf16_t* dst, const float* g2 = nullptr, const float* mod2 = nullptr, bf16_t* dst2 = nullptr) {
    const int tid0 = opaque_tid(wv), w = tid0 >> 6, lane = tid0 & 63;
    for (int row = (opaque_bid() * 8 + w) * 4; row < T; row += gridDim.x * 32) {
        const int b = row >> 12; const float* xr = x + (size_t)row * 1024;
        f32x4 v[4][4]; float ss[4];
#pragma unroll
        for (int r = 0; r < 4; ++r)
#pragma unroll
            for (int j = 0; j < 4; ++j) v[r][j] = *(const f32x4*)(xr + r * 1024 + lane * 4 + j * 256);
#pragma unroll
        for (int r = 0; r < 4; ++r) { float q = 0.f;
#pragma unroll
            for (int j = 0; j < 4; ++j) q += v[r][j][0] * v[r][j][0] + v[r][j][1] * v[r][j][1] + v[r][j][2] * v[r][j][2] + v[r][j][3] * v[r][j][3];
            q += dpp_f(q, 0xB1); q += dpp_f(q, 0x4E); q += dpp_f(q, 0x141); q += dpp_f(q, 0x140); q += shx(q, 16, lane); q += shx(q, 32, lane);
            ss[r] = rsqrtf(q * (1.0f / 1024.0f) + EPS); }
        const float* mb = mod + (size_t)b * MODW;
#pragma unroll
        for (int j = 0; j < 4; ++j) { const int col = lane * 4 + j * 256;
            const f32x4 gg = *(const f32x4*)(g + col), sh = *(const f32x4*)(mb + col), sc = *(const f32x4*)(mb + 1024 + col);
            const f32x4 gs = gg * (sc + 1.0f);
#pragma unroll
            for (int r = 0; r < 4; ++r) { const f32x4 h = v[r][j] * ss[r] * gs + sh;
                u32x2 wv; wv.x = cvt_pk_bf16(h[0], h[1]); wv.y = cvt_pk_bf16(h[2], h[3]);
                *(u32x2*)(dst + (size_t)(row + r) * 1024 + col) = wv; }
            if (dst2) { const float* mb2 = mod2 + (size_t)b * MODW;
                const f32x4 gg2 = *(const f32x4*)(g2 + col), sh2 = *(const f32x4*)(mb2 + col), sc2 = *(const f32x4*)(mb2 + 1024 + col);
                const f32x4 gs2 = gg2 * (sc2 + 1.0f);
#pragma unroll
                for (int r = 0; r < 4; ++r) { const f32x4 h = v[r][j] * ss[r] * gs2 + sh2;
                    u32x2 wv; wv.x = cvt_pk_bf16(h[0], h[1]); wv.y = cvt_pk_bf16(h[2], h[3]);
                    *(u32x2*)(dst2 + (size_t)(row + r) * 1024 + col) = wv; } } }
    }
}

__device__ void mix_phase(int wv, const Params& p, LAS unsigned char* lds, int l) {
    const int tid = opaque_tid(wv), w = __builtin_amdgcn_readfirstlane(tid >> 6), lane = tid & 63, fr = lane & 15, fq = lane >> 4;
    const bf16_t* VgT = (const bf16_t*)(p.ws + WS_BUF1); bf16_t* mixed = (bf16_t*)(p.ws + WS_BUF2);
    const float* part = (const float*)(p.ws + WS_PART);
    const float* Wsp = p.in[7] + (size_t)l * 8 * 128 * 128; const float* bsp = p.in[8] + (size_t)l * 8 * 128; const float* sgu = p.in[6] + (size_t)l * 2048;
    LAS float* rs = (LAS float*)(lds + 32768);
    bf16x8 afN[2][4]; f32x4 wsN[4][2]; f32x4 ptN[4];
#define MIX_LOAD(U) do { const int g_ = (U) & 7, c_ = (U) >> 3; \
        _Pragma("unroll") for (int mt = 0; mt < 2; ++mt) _Pragma("unroll") for (int ks = 0; ks < 4; ++ks) \
            afN[mt][ks] = *(const bf16x8*)(VgT + ((size_t)c_ * 8 + g_) * 32768 + (w * 32 + (fr >> 2) * 8 + mt * 4 + (fr & 3)) * 128 + ks * 32 + fq * 8); \
        _Pragma("unroll") for (int it = 0; it < 4; ++it) { const int idx = it * 512 + tid, t = idx >> 4, cs = idx & 15; const float* wp = Wsp + ((size_t)g_ * 128 + t) * 128 + cs * 8; \
            wsN[it][0] = *(const f32x4*)wp; wsN[it][1] = *(const f32x4*)(wp + 4); } \
        if (tid < 128) { const float* pp = part + (size_t)(c_ * 128 + tid) * 16; _Pragma("unroll") for (int i = 0; i < 4; ++i) ptN[i] = *(const f32x4*)(pp + i * 4); } } while (0)
    int u = opaque_bid();
    if (u < 2048) MIX_LOAD(u);
    for (; u < 2048; u += gridDim.x) {
        const int g = u & 7, c = u >> 3;
        bf16x8 af[2][4]; f32x4 ws[4][2];
#pragma unroll
        for (int mt = 0; mt < 2; ++mt)
#pragma unroll
            for (int ks = 0; ks < 4; ++ks) af[mt][ks] = afN[mt][ks];
#pragma unroll
        for (int it = 0; it < 4; ++it) { ws[it][0] = wsN[it][0]; ws[it][1] = wsN[it][1]; }
        __syncthreads();
        if (tid < 128) { float s = 0.f;
#pragma unroll
            for (int i = 0; i < 4; ++i) { const f32x4 q = ptN[i]; s += q[0] + q[1] + q[2] + q[3]; }
            rs[tid] = rsqrtf(s * (1.0f / 2048.0f) + EPS); }
        __syncthreads();
#pragma unroll
        for (int it = 0; it < 4; ++it) { const int idx = it * 512 + tid, t = idx >> 4, cs = idx & 15, s0 = cs * 8;
            const f32x4 w0 = ws[it][0], w1 = ws[it][1];
            float v[8];
#pragma unroll
            for (int e = 0; e < 4; ++e) { v[e] = (s0 + e <= t) ? w0[e] * rs[s0 + e] : 0.f; v[4 + e] = (s0 + 4 + e <= t) ? w1[e] * rs[s0 + 4 + e] : 0.f; }
            u32x4 pk; pk.x = cvt_pk_bf16(v[0], v[1]); pk.y = cvt_pk_bf16(v[2], v[3]); pk.z = cvt_pk_bf16(v[4], v[5]); pk.w = cvt_pk_bf16(v[6], v[7]);
            *(LAS u32x4*)(lds + t * 256 + ((cs ^ (t & 15)) << 4)) = pk; }
        float bbv[8]; f32x4 sg0, sg1;
#pragma unroll
        for (int nt = 0; nt < 8; ++nt) bbv[nt] = bsp[g * 128 + nt * 16 + fr];
        { const int e0 = g * 256 + w * 32 + fq * 8; sg0 = *(const f32x4*)(sgu + e0); sg1 = *(const f32x4*)(sgu + e0 + 4); }
        if (u + (int)gridDim.x < 2048) MIX_LOAD(u + (int)gridDim.x);
        __syncthreads();
#pragma unroll
        for (int nt = 0; nt < 8; ++nt) {
            f32x4 acc0 = {0.f, 0.f, 0.f, 0.f}, acc1 = {0.f, 0.f, 0.f, 0.f};
#pragma unroll
            for (int ks = 0; ks < 4; ++ks) {
                if (ks * 32 <= nt * 16 + 15) {
                    const bf16x8 bfr = *(const LAS bf16x8*)(lds + (nt * 16 + fr) * 256 + (((ks * 4 + fq) ^ fr) << 4));
                    acc0 = __builtin_amdgcn_mfma_f32_16x16x32_bf16(af[0][ks], bfr, acc0, 0, 0, 0);
                    acc1 = __builtin_amdgcn_mfma_f32_16x16x32_bf16(af[1][ks], bfr, acc1, 0, 0, 0);
                }
            }
            const int tl = nt * 16 + fr; const size_t token = (size_t)c * 128 + tl; const float bb = bbv[nt];
            { const int e0 = g * 256 + w * 32 + fq * 8;
              u32x4 wv; wv.x = cvt_pk_bf16(acc0[0] * sg0[0] + bb, acc0[1] * sg0[1] + bb); wv.y = cvt_pk_bf16(acc0[2] * sg0[2] + bb, acc0[3] * sg0[3] + bb);
              wv.z = cvt_pk_bf16(acc1[0] * sg1[0] + bb, acc1[1] * sg1[1] + bb); wv.w = cvt_pk_bf16(acc1[2] * sg1[2] + bb, acc1[3] * sg1[3] + bb);
              *(u32x4*)(mixed + token * 2048 + e0) = wv; }
        }
    }
#undef MIX_LOAD
}

constexpr int VPITCH = 528;
__device__ void attn_phase(int wv, const Params& p, LAS unsigned char* lds, int l, int mode) {
    const int tid = opaque_tid(wv), w = __builtin_amdgcn_readfirstlane(tid >> 6), lane = tid & 63, fr = lane & 15, fq = lane >> 4;
    LAS unsigned char* Ks = lds; LAS unsigned char* Vs = lds + 65536;
    const float* qg = p.in[19] + (size_t)l * 128; const float* kg = p.in[14];
    float* LSE = (float*)(p.ws + WS_LSE);
    int u0 = opaque_bid(); { const int Gx = gridDim.x; if ((Gx & 7) == 0) u0 = (u0 & 7) * (Gx >> 3) + (u0 >> 3); }
    for (int u = (mode ? 1024 : 0) + u0; u < (mode ? 1536 : 1024); u += gridDim.x) {
        const int k = u & 1; int t = u >> 1; const int blk = ((t & 31) + 5 * (u / (int)gridDim.x)) & 31; t >>= 5; const int b = t & 7, g = t >> 3;
        const int dsh = 2 * g, nbk = 32 >> dsh, n = blk & (nbk - 1);
        bf16_t* QO = (bf16_t*)(p.ws + WS_QO) + (size_t)g * T * 1024;
        const bf16_t* Kd = (const bf16_t*)(p.ws + WS_KD) + (size_t)g * T * 256;
        const bf16_t* Vt = (const bf16_t*)(p.ws + WS_VT) + (size_t)g * 256 * T;
        const size_t row0 = (size_t)b * SEQ + blk * 128;
        int tl = tid; asm volatile("" : "+v"(tl));
        const int lfr = tl & 15, lfq = (tl >> 4) & 3;
        const int j = k * 4 + (w >> 1);
        const char* qbase = (const char*)(QO + ((size_t)(b * 8 + j) * 4096 + blk * 128 + (w & 1) * 64) * 128);
        const unsigned qoff = (unsigned)(lfr * 256 + lfq * 16);
        u32x4 raw[2][4];
#pragma unroll
        for (int qt = 0; qt < 2; ++qt)
#pragma unroll
            for (int ks = 0; ks < 4; ++ks) raw[qt][ks] = *(const u32x4*)(qbase + (qoff + qt * 4096 + ks * 64));
        __syncthreads();
        float mqc;
        {
            const char* kbase = (const char*)(Kd + ((size_t)(b * 2 + k) * 4096 + blk * 128 - 128) * 128);
            const char* vbase = (const char*)(Vt + ((size_t)((b * 2 + k) * 32 + blk - 1) * 128) * 128);
            f32x4 G0, G1;
            { const int h0 = (tl & 15) * 8; const f32x4 qa = *(const f32x4*)(qg + h0), qb = *(const f32x4*)(qg + h0 + 4), ka = *(const f32x4*)(kg + h0), kb = *(const f32x4*)(kg + h0 + 4); G0 = qa * ka; G1 = qb * kb; }
            u32x4 kraw[8], vraw[8];
#pragma unroll
            for (int it = 0; it < 8; ++it) { const int idx = it * 512 + tl; int row = idx >> 4; const int c = idx & 15; if (n == 0 && it < 4) row += 128;
                kraw[it] = *(const u32x4*)(kbase + (unsigned)(row * 256 + c * 16)); }
#pragma unroll
            for (int it = 0; it < 8; ++it) { const int idx = it * 512 + tl, h = idx >> 5; int c = idx & 31; if (n == 0 && c < 16) c += 16;
                vraw[it] = *(const u32x4*)(vbase + (unsigned)((c >> 4) * 32768 + h * 256 + (c & 15) * 16)); }
#pragma unroll
            for (int it = 0; it < 8; ++it) { const int idx = it * 512 + tl, row = idx >> 4, c = idx & 15; const u32x4 raw = kraw[it];
                float v[8]; v[0] = bf_lo(raw.x); v[1] = bf_hi(raw.x); v[2] = bf_lo(raw.y); v[3] = bf_hi(raw.y); v[4] = bf_lo(raw.z); v[5] = bf_hi(raw.z); v[6] = bf_lo(raw.w); v[7] = bf_hi(raw.w);
                float ss = 0.f;
#pragma unroll
                for (int e = 0; e < 8; ++e) ss += v[e] * v[e];
                ss += dpp_f(ss, 0xB1); ss += dpp_f(ss, 0x4E); ss += dpp_f(ss, 0x141); ss += dpp_f(ss, 0x140);
                const float rstd = rsqrtf(ss * (1.0f / 128.0f) + EPS);
                const f32x4 g0 = G0 * rstd, g1 = G1 * rstd;
                u32x4 pk; pk.x = cvt_pk_bf16(v[0] * g0[0], v[1] * g0[1]); pk.y = cvt_pk_bf16(v[2] * g0[2], v[3] * g0[3]); pk.z = cvt_pk_bf16(v[4] * g1[0], v[5] * g1[1]); pk.w = cvt_pk_bf16(v[6] * g1[2], v[7] * g1[3]);
                *(LAS u32x4*)(Ks + row * 256 + ((c ^ (row & 15)) << 4)) = pk; }
            { float gm = fmaxf(fmaxf(fmaxf(fabsf(G0[0]), fabsf(G0[1])), fmaxf(fabsf(G0[2]), fabsf(G0[3]))), fmaxf(fmaxf(fabsf(G1[0]), fabsf(G1[1])), fmaxf(fabsf(G1[2]), fabsf(G1[3]))));
              gm = fmaxf(gm, dpp_f(gm, 0xB1)); gm = fmaxf(gm, dpp_f(gm, 0x4E)); gm = fmaxf(gm, dpp_f(gm, 0x141)); gm = fmaxf(gm, dpp_f(gm, 0x140));
              mqc = gm * (0.08838834764831845f * LOG2E * 128.0f * 1.01f) + 0.05f; }
#pragma unroll
            for (int it = 0; it < 8; ++it) { const int idx = it * 512 + tl, h = idx >> 5, c = idx & 31;
                *(LAS u32x4*)(Vs + h * VPITCH + c * 16) = vraw[it]; }
        }
        __syncthreads();
        const float slope = exp2f(-8.0f * (float)(g * 8 + j + 1) / 24.0f);
        const float nsl = -slope * (float)(1 << dsh) * LOG2E;
#pragma unroll 1
        for (int sub = 0; sub < 2; ++sub) {
            const int i0 = (w & 1) * 64 + sub * 32;
            bf16x8 qf[2][4]; float mq[2];
            {
                if (sub == 1) {
#pragma unroll
                    for (int qt = 0; qt < 2; ++qt)
#pragma unroll
                        for (int ks = 0; ks < 4; ++ks) raw[qt][ks] = *(const u32x4*)(qbase + (qoff + 8192 + qt * 4096 + ks * 64));
                }
                float rq[2];
#pragma unroll
                for (int qt = 0; qt < 2; ++qt) { float ss = 0.f;
#pragma unroll
                    for (int ks = 0; ks < 4; ++ks) { const u32x4 r = raw[qt][ks];
                        ss += bf_lo(r.x) * bf_lo(r.x) + bf_hi(r.x) * bf_hi(r.x) + bf_lo(r.y) * bf_lo(r.y) + bf_hi(r.y) * bf_hi(r.y) + bf_lo(r.z) * bf_lo(r.z) + bf_hi(r.z) * bf_hi(r.z) + bf_lo(r.w) * bf_lo(r.w) + bf_hi(r.w) * bf_hi(r.w); }
                    ss += shx(ss, 16, lane); ss += shx(ss, 32, lane);
                    rq[qt] = rsqrtf(ss * (1.0f / 128.0f) + EPS) * (0.08838834764831845f * LOG2E); }
#pragma unroll
                for (int ks = 0; ks < 4; ++ks)
#pragma unroll
                    for (int qt = 0; qt < 2; ++qt) { const u32x4 r = raw[qt][ks]; const float sc = rq[qt];
                        u32x4 pk; pk.x = cvt_pk_bf16(bf_lo(r.x) * sc, bf_hi(r.x) * sc); pk.y = cvt_pk_bf16(bf_lo(r.y) * sc, bf_hi(r.y) * sc); pk.z = cvt_pk_bf16(bf_lo(r.z) * sc, bf_hi(r.z) * sc); pk.w = cvt_pk_bf16(bf_lo(r.w) * sc, bf_hi(r.w) * sc);
                        qf[qt][ks] = __builtin_bit_cast(bf16x8, pk); }
                mq[0] = mqc; mq[1] = mqc;
            }
            float lrun[2] = {0.f, 0.f};
            f32x4 oacc[8][2];
#pragma unroll
            for (int ht = 0; ht < 8; ++ht) { oacc[ht][0] = (f32x4){0.f, 0.f, 0.f, 0.f}; oacc[ht][1] = (f32x4){0.f, 0.f, 0.f, 0.f}; }
            const int kc0 = i0 >> 5; int kc_lo = kc0; const int kc_hi = kc0 + 5; if (n == 0 && kc_lo < 4) kc_lo = 4;
            bf16x8 kfr[2][4];
#define LOADK(KC) do { _Pragma("unroll") for (int kt = 0; kt < 2; ++kt) _Pragma("unroll") for (int ks = 0; ks < 4; ++ks) \
                kfr[kt][ks] = *(const LAS bf16x8*)(Ks + ((KC) * 32 + kt * 16 + fr) * 256 + (((ks * 4 + fq) ^ fr) << 4)); } while (0)
#pragma unroll 1
            for (int kc = kc_lo; kc < kc_hi; ++kc) {
                LOADK(kc);
                u32x2 vlo[8], vhi[8];
#pragma unroll
                for (int ht = 0; ht < 4; ++ht) { const LAS unsigned char* vp = Vs + ((ht >> 1) * 32 + (fr >> 2) * 8 + (ht & 1) * 4 + (fr & 3)) * VPITCH + (kc * 32 + fq * 4) * 2;
                    vlo[ht] = *(const LAS u32x2*)vp; vhi[ht] = *(const LAS u32x2*)(vp + 32); }
                __builtin_amdgcn_sched_barrier(0);
                f32x4 sacc[2][2];
#pragma unroll
                for (int qt = 0; qt < 2; ++qt) { const float c0 = nsl * (float)(128 + i0 + qt * 16 + fr - kc * 32 - fq * 4) - mq[qt];
#pragma unroll
                    for (int kt = 0; kt < 2; ++kt)
#pragma unroll
                        for (int e = 0; e < 4; ++e) sacc[kt][qt][e] = c0 - nsl * (float)(kt * 16 + e); }
#pragma unroll
                for (int ks = 0; ks < 4; ++ks)
#pragma unroll
                    for (int kt = 0; kt < 2; ++kt) {
                        sacc[kt][0] = __builtin_amdgcn_mfma_f32_16x16x32_bf16(kfr[kt][ks], qf[0][ks], sacc[kt][0], 0, 0, 0);
                        sacc[kt][1] = __builtin_amdgcn_mfma_f32_16x16x32_bf16(kfr[kt][ks], qf[1][ks], sacc[kt][1], 0, 0, 0); }
                __builtin_amdgcn_sched_barrier(0);
#pragma unroll
                for (int ht = 4; ht < 8; ++ht) { const LAS unsigned char* vp = Vs + ((ht >> 1) * 32 + (fr >> 2) * 8 + (ht & 1) * 4 + (fr & 3)) * VPITCH + (kc * 32 + fq * 4) * 2;
                    vlo[ht] = *(const LAS u32x2*)vp; vhi[ht] = *(const LAS u32x2*)(vp + 32); }
                __builtin_amdgcn_sched_barrier(0);
                const bool edge = (kc == kc0) || (kc == kc0 + 4);
                bf16x8 pf[2];
#pragma unroll
                for (int qt = 0; qt < 2; ++qt) {
                    float ps = 0.f;
                    if (edge) {
                        const int iq = i0 + qt * 16 + fr;
#pragma unroll
                        for (int kt = 0; kt < 2; ++kt)
#pragma unroll
                            for (int e = 0; e < 4; ++e) { const int jk = kc * 32 + kt * 16 + fq * 4 + e, dq = 128 + iq - jk;
                                const float pv = (dq >= 0 && dq <= 128) ? ex2(sacc[kt][qt][e]) : 0.f; sacc[kt][qt][e] = pv; ps += pv; }
                    } else {
#pragma unroll
                        for (int kt = 0; kt < 2; ++kt)
#pragma unroll
                            for (int e = 0; e < 4; ++e) { const float pv = ex2(sacc[kt][qt][e]); sacc[kt][qt][e] = pv; ps += pv; }
                    }
                    lrun[qt] += ps;
                    u32x4 pk; pk.x = cvt_pk_bf16(sacc[0][qt][0], sacc[0][qt][1]); pk.y = cvt_pk_bf16(sacc[0][qt][2], sacc[0][qt][3]);
                    pk.z = cvt_pk_bf16(sacc[1][qt][0], sacc[1][qt][1]); pk.w = cvt_pk_bf16(sacc[1][qt][2], sacc[1][qt][3]);
                    pf[qt] = __builtin_bit_cast(bf16x8, pk);
                }
#pragma unroll
                for (int ht = 0; ht < 8; ++ht) {
                    u32x4 vv; vv.x = vlo[ht].x; vv.y = vlo[ht].y; vv.z = vhi[ht].x; vv.w = vhi[ht].y;
                    const bf16x8 vf = __builtin_bit_cast(bf16x8, vv);
                    oacc[ht][0] = __builtin_amdgcn_mfma_f32_16x16x32_bf16(vf, pf[0], oacc[ht][0], 0, 0, 0);
                    oacc[ht][1] = __builtin_amdgcn_mfma_f32_16x16x32_bf16(vf, pf[1], oacc[ht][1], 0, 0, 0); }
            }
#undef LOADK
#pragma unroll
            for (int qt = 0; qt < 2; ++qt) {
                float lt = lrun[qt]; lt += shx(lt, 16, lane); lt += shx(lt, 32, lane);
                const float inv = 1.0f / lt; const size_t row = row0 + i0 + qt * 16 + fr;
                char* obase = (char*)qbase + (unsigned)(lfr * 256 + lfq * 16 + sub * 8192 + qt * 4096);
                const float lse_here = (mq[qt] + log2f(lt)) * LN2;
                if (mode == 0) {
#pragma unroll
                    for (int pp = 0; pp < 4; ++pp) { const f32x4 o0 = oacc[2 * pp][qt] * inv, o1 = oacc[2 * pp + 1][qt] * inv;
                        u32x4 wv; wv.x = cvt_pk_bf16(o0[0], o0[1]); wv.y = cvt_pk_bf16(o0[2], o0[3]); wv.z = cvt_pk_bf16(o1[0], o1[1]); wv.w = cvt_pk_bf16(o1[2], o1[3]);
                        *(u32x4*)(obase + pp * 64) = wv; }
                    if (fq == 0) LSE[((size_t)g * T + row) * 8 + j] = lse_here;
                } else {
                    const int pos = (int)(row - (size_t)b * SEQ), sq = (pos & 255) * 16 + (pos >> 8), p1 = (sq & 3) * 1024 + (sq >> 2);
                    const bf16_t* o0b = (const bf16_t*)(p.ws + WS_QO) + (size_t)(b * 8 + j) * 4096 * 128; const bf16_t* o1b = o0b + (size_t)T * 1024;
                    const bf16_t* zb = (const bf16_t*)(p.ws + WS_ZS) + (size_t)b * SEQ * 1024 + j * 128; bf16_t* yb = (bf16_t*)(p.ws + WS_HB) + (size_t)b * SEQ * 1024 + j * 128;
                    const unsigned oa = (unsigned)(sq * 128 + lfq * 8), ob = (unsigned)(p1 * 128 + lfq * 8), oz = (unsigned)(sq * 1024 + lfq * 8);
                    const float l0 = LSE[((size_t)b * SEQ + sq) * 8 + j], l1 = LSE[((size_t)T + (size_t)b * SEQ + p1) * 8 + j];
                    const float mx = fmaxf(l0, fmaxf(l1, lse_here));
                    float e0 = ex2((l0 - mx) * LOG2E), e1 = ex2((l1 - mx) * LOG2E), e2 = ex2((lse_here - mx) * LOG2E);
                    const float ei = 1.0f / (e0 + e1 + e2); e0 *= ei; e1 *= ei; e2 *= ei * inv;
#pragma unroll
                    for (int ph2 = 0; ph2 < 2; ++ph2) {
                        u32x4 a0[2], a1[2], zz[2];
#pragma unroll
                        for (int q2 = 0; q2 < 2; ++q2) { const int pp = ph2 * 2 + q2; a0[q2] = *(const u32x4*)(o0b + (oa + pp * 32)); a1[q2] = *(const u32x4*)(o1b + (ob + pp * 32)); zz[q2] = *(const u32x4*)(zb + (oz + pp * 32)); }
#pragma unroll
                        for (int q2 = 0; q2 < 2; ++q2) { const int pp = ph2 * 2 + q2; const f32x4 o0 = oacc[2 * pp][qt], o1 = oacc[2 * pp + 1][qt]; u32x4 y;
#define MRG2(c, va, vb) cvt_pk_bf16((e0 * bf_lo(a0[q2].c) + e1 * bf_lo(a1[q2].c) + e2 * (va)) * bf_lo(zz[q2].c), (e0 * bf_hi(a0[q2].c) + e1 * bf_hi(a1[q2].c) + e2 * (vb)) * bf_hi(zz[q2].c))
                            y.x = MRG2(x, o0[0], o0[1]); y.y = MRG2(y, o0[2], o0[3]); y.z = MRG2(z, o1[0], o1[1]); y.w = MRG2(w, o1[2], o1[3]);
#undef MRG2
                            *(u32x4*)(yb + (oz + pp * 32)) = y; }
                    }
                }
            }
        }
    }
}

__device__ void merge_phase(int wv, const Params& p) {
    const int tid0 = opaque_tid(wv), w = tid0 >> 6, lane = tid0 & 63;
    const bf16_t* QO = (const bf16_t*)(p.ws + WS_QO); const float* LSE = (const float*)(p.ws + WS_LSE);
    const bf16_t* Zs = (const bf16_t*)(p.ws + WS_ZS); bf16_t* Y = (bf16_t*)(p.ws + WS_HB);
    for (int t = opaque_bid() * 8 + w; t < T; t += gridDim.x * 8) {
        const int b = t >> 12, s = t & 4095;
        const size_t r0 = (size_t)t, r1 = (size_t)b * SEQ + (s & 3) * 1024 + (s >> 2), r2 = (size_t)b * SEQ + (s & 15) * 256 + (s >> 4);
        float l0[2], l1[2], l2[2]; u32x4 o0[2], o1[2], o2[2], z[2];
#pragma unroll
        for (int i = 0; i < 2; ++i) {
            const int col = lane * 8 + i * 512, head = col >> 7;
            l0[i] = LSE[(r0) * 8 + head]; l1[i] = LSE[((size_t)T + r1) * 8 + head]; l2[i] = LSE[((size_t)2 * T + r2) * 8 + head];
            { const size_t hb = (size_t)(b * 8 + head) * 4096; const int hh = col & 127;
              o0[i] = *(const u32x4*)(QO + (hb + (r0 & 4095)) * 128 + hh); o1[i] = *(const u32x4*)(QO + (size_t)T * 1024 + (hb + (r1 & 4095)) * 128 + hh); o2[i] = *(const u32x4*)(QO + (size_t)2 * T * 1024 + (hb + (r2 & 4095)) * 128 + hh); }
            z[i] = *(const u32x4*)(Zs + (size_t)t * 1024 + col);
        }
#pragma unroll
        for (int i = 0; i < 2; ++i) {
            const int col = lane * 8 + i * 512;
            const float mx = fmaxf(l0[i], fmaxf(l1[i], l2[i]));
            float e0 = ex2((l0[i] - mx) * LOG2E), e1 = ex2((l1[i] - mx) * LOG2E), e2 = ex2((l2[i] - mx) * LOG2E);
            const float inv = 1.0f / (e0 + e1 + e2); e0 *= inv; e1 *= inv; e2 *= inv;
            u32x4 y;
#define MRG(c) cvt_pk_bf16((e0 * bf_lo(o0[i].c) + e1 * bf_lo(o1[i].c) + e2 * bf_lo(o2[i].c)) * bf_lo(z[i].c), (e0 * bf_hi(o0[i].c) + e1 * bf_hi(o1[i].c) + e2 * bf_hi(o2[i].c)) * bf_hi(z[i].c))
            y.x = MRG(x); y.y = MRG(y); y.z = MRG(z); y.w = MRG(w);
#undef MRG
            *(u32x4*)(Y + (size_t)t * 1024 + col) = y;
        }
    }
}

#define XB_TMO      128
#define XB_XCNT(j)  (256  + 64 * (j))
#define XB_XSUB(j)  (1280 + 64 * (j))
#define XB_XGEN(j)  (2304 + 64 * (j))
#define XB_TOP      3328
#define XB_TOPGEN   3392
#define XCD_BAR_WORDS 3456
#define XB_SPIN_CAP (1u << 22)
__device__ __forceinline__ unsigned xb_ld(unsigned* p)              { return __hip_atomic_load(p, __ATOMIC_RELAXED, __HIP_MEMORY_SCOPE_AGENT); }
__device__ __forceinline__ unsigned xb_add(unsigned* p, unsigned v) { return __hip_atomic_fetch_add(p, v, __ATOMIC_RELAXED, __HIP_MEMORY_SCOPE_AGENT); }
__device__ __forceinline__ unsigned xb_xcc_id() { return (unsigned)__builtin_amdgcn_s_getreg((3 << 11) | 20) & 0xFu; }
#define XB_SPIN(cond, bar) do { unsigned _sp = 0; while (cond) { __builtin_amdgcn_s_sleep(1); \
    if ((++_sp & 255u) == 0u) { if (xb_ld(&(bar)[XB_TMO])) break; if (_sp > XB_SPIN_CAP) { atomicAdd(&(bar)[XB_TMO], 1u); break; } } } } while (0)
struct XcdBarrier { unsigned* bar; unsigned x; volatile LAS unsigned* st; };
__device__ __forceinline__ XcdBarrier xcd_barrier_post(unsigned* bar, volatile LAS unsigned* st) {
    XcdBarrier b; b.bar = bar; b.x = xb_xcc_id(); b.st = st;
    if (threadIdx.x == 0) (void)xb_add(&bar[XB_XCNT(b.x)], 1u);
    return b;
}
__device__ __forceinline__ void xcd_barrier_complete(unsigned* bar, unsigned x, unsigned& nloc, unsigned& nx) {
    const unsigned G = gridDim.x * gridDim.y * gridDim.z;
    unsigned sum, cnt, mine, sp = 0u;
    for (;;) {
        sum = 0u; cnt = 0u; mine = 0u;
#pragma unroll
        for (unsigned j = 0; j < 16; ++j) { const unsigned c = xb_ld(&bar[XB_XCNT(j)]); sum += c; cnt += (c > 0u) ? 1u : 0u; mine = (j == x) ? c : mine; }
        if (sum == G) break;
        __builtin_amdgcn_s_sleep(1);
        if ((++sp & 255u) == 0u) { if (xb_ld(&bar[XB_TMO])) break; if (sp > XB_SPIN_CAP) { atomicAdd(&bar[XB_TMO], 1u); break; } }
    }
    nloc = mine > 0u ? mine : 1u; nx = cnt > 0u ? cnt : 1u;
}
__device__ __forceinline__ void xcd_barrier(const XcdBarrier& b, bool leader) {
    asm volatile("s_waitcnt vmcnt(0)" ::: "memory");
    __syncthreads();
    if (leader) {
        unsigned* bar = b.bar;
        __builtin_amdgcn_s_waitcnt(0);
        unsigned nloc = b.st[0], nx = b.st[1];
        if (nloc == 0u) { xcd_barrier_complete(bar, b.x, nloc, nx); b.st[0] = nloc; b.st[1] = nx; }
        const unsigned old = xb_add(&bar[XB_XSUB(b.x)], 1u);
        const unsigned gen = old / nloc;
        if (old + 1u == (gen + 1u) * nloc) {
            __builtin_amdgcn_fence(__ATOMIC_RELEASE, "agent");
            asm volatile("s_waitcnt vmcnt(0)" ::: "memory");
            const unsigned og = xb_add(&bar[XB_TOP], 1u);
            const unsigned tg = og / nx;
            if (og + 1u == (tg + 1u) * nx) xb_add(&bar[XB_TOPGEN], 1u);
            else XB_SPIN(xb_ld(&bar[XB_TOPGEN]) == tg, bar);
            __builtin_amdgcn_fence(__ATOMIC_ACQUIRE, "agent");
            xb_add(&bar[XB_XGEN(b.x)], 1u);
            asm volatile("s_waitcnt vmcnt(0)" ::: "memory");
        } else {
            XB_SPIN(xb_ld(&bar[XB_XGEN(b.x)]) == gen, bar);
            __builtin_amdgcn_fence(__ATOMIC_ACQUIRE, "agent");
            asm volatile("s_waitcnt vmcnt(0)" ::: "memory");
        }
    }
    __syncthreads();
}

constexpr int NPH = 22;
__global__ void __launch_bounds__(512, 2) yoco_fwd(Params p) {
    extern __shared__ __attribute__((aligned(16))) unsigned char shm[];
    LAS unsigned char* lds = (LAS unsigned char*)shm;
    cg::grid_group grid = cg::this_grid();
    if (p.never) grid.sync();
    volatile LAS unsigned* xst = (volatile LAS unsigned*)(lds + LDS_BYTES - 16);
    if (threadIdx.x < 4) xst[threadIdx.x] = 0u;
    __syncthreads();
    const XcdBarrier xbar = xcd_barrier_post((unsigned*)p.ws, xst);
    const int wv = __builtin_amdgcn_readfirstlane((int)(threadIdx.x >> 6));
#define GSYNC() xcd_barrier(xbar, opaque_tid(wv) == 0)
    const int G = gridDim.x;
#pragma unroll 1
    for (int ph = 0; ph < NPH; ++ph) {
        const int bid = opaque_bid();
        unsigned char* ws = p.ws;
        const float* MOD = (const float*)(ws + WS_MOD);
        int kind, l;
        if (ph == 0) { kind = 0; l = 0; }
        else if (ph <= 10) { l = (ph - 1) / 5; kind = 1 + (ph - 1) % 5; }
        else if (ph == 11) { kind = 6; l = 0; }
        else if (ph == 12) { kind = 7; l = 0; }
        else if (ph == 17) { kind = 11; l = 1; }
        else { l = ph >= 18 ? 1 : 0; const int q = (ph - (l ? 18 : 13)); kind = q == 0 ? 8 : q == 1 ? 9 : q == 2 ? 10 : 5; }
        const bool layerB = ph > 10;
        const int kind0 = kind; const int nrep = ((PH_REP >> kind0) & 1) ? (kind0 == 9 ? 3 : 2) : 1;
#pragma unroll 1
        for (int rep = 0; rep < nrep; ++rep) {
        kind = (kind0 == 9 && rep == 1) ? 8 : kind0; if (rep > 0 && kind0 == 9) GSYNC();
        if (kind == 0) { if (PH_MASK & 1) phase0(wv, p, lds); }
        else if (kind == 1) { if (PH_MASK & 2) norm_phase(wv, l == 0 ? p.in[0] : p.out, p.in[4] + l * 1024, MOD + l * 3072, (bf16_t*)(ws + WS_H)); }
        else if (kind == 2) { if (PH_MASK & 4) {
            pg8::Gemm g{(const bf16_t*)(ws + WS_WVA) + (size_t)l * 2048 * 1024, (const bf16_t*)(ws + WS_H), 1024, 1024, 1024, 0, 0}; pg8::StaticOrder S; S.init(2048, T, G, bid);
            EpiVg E{(bf16_t*)(ws + WS_BUF1), (float*)(ws + WS_PART)}; pg8::gemm_phase<EpiVg>(wv, lds, g, S, E); } }
        else if (kind == 3) { if (PH_MASK & 8) mix_phase(wv, p, lds, l); }
        else if (kind == 4) { if (PH_MASK & 16) {
            pg8::Gemm g{(const bf16_t*)(ws + WS_H), (const bf16_t*)(ws + WS_WUZ) + (size_t)l * 4096 * 1024, 1024, 1024, 1024, 0, 0}; pg8::StaticOrder S; S.init(T, 4096, G, bid);
            EpiUZ E{(const bf16_t*)(ws + WS_BUF2), (bf16_t*)(ws + WS_BUF1)}; pg8::gemm_phase<EpiUZ>(wv, lds, g, S, E); } }
        else if (kind == 5) { if (PH_MASK & 32) {
            pg8::Gemm g; g.dilA = 0; g.dilB = 0; const float* base; const float* gate;
            if (!layerB) { g.A = (const bf16_t*)(ws + WS_BUF1); g.Bt = (const bf16_t*)(ws + WS_WOA) + (size_t)l * 1024 * 2048; g.lda = 2048; g.ldb = 2048; g.K = 2048; base = (l == 0) ? p.in[0] : p.out; gate = MOD + l * 3072 + 2048; }
            else { g.A = (const bf16_t*)(ws + WS_HB); g.Bt = (const bf16_t*)(ws + WS_WOB) + (size_t)l * 1024 * 1024; g.lda = 1024; g.ldb = 1024; g.K = 1024; base = p.out; gate = MOD + 8192 + l * 3072 + 2048; }
            pg8::StaticOrder S; S.init(T, 1024, G, bid);
            EpiOut E{base, p.out, gate}; pg8::gemm_phase<EpiOut>(wv, lds, g, S, E); } }
        else if (kind == 6) { if (PH_MASK & 2) { norm_phase(wv, p.out, p.in[12], MOD + 6144, (bf16_t*)(ws + WS_ZS), p.in[17], MOD + 8192, (bf16_t*)(ws + WS_HB)); } }
        else if (kind == 11) { if (PH_MASK & 2) norm_phase(wv, p.out, p.in[17] + 1024, MOD + 8192 + 3072, (bf16_t*)(ws + WS_HB)); }
        else if (kind == 7 || kind == 8) { if (PH_MASK & 64) {
            const int ncall = kind == 7 ? 6 : 1;
#pragma unroll 1
            for (int ci = 0; ci < ncall; ++ci) {
                pg8::Gemm g; g.K = 1024; pg8::StaticOrder S; EpiBf16 E; E.ACT = 0; E.O2 = nullptr;
                if (kind == 7) {
                    const int gq = ci % 3, d = 1 << (2 * gq); const bf16_t* HKV = (const bf16_t*)(ws + WS_ZS); const bf16_t* WKV = (const bf16_t*)(ws + WS_WKV);
                    if (ci < 3) { g.A = HKV; g.Bt = WKV + (size_t)gq * 256 * 1024; g.lda = d * 1024; g.ldb = 1024; g.dilA = d; g.dilB = 0; S.init(T, 256, G, (bid + (ci & 1) * 128) % G);
                        E.O = (bf16_t*)(ws + WS_KD) + (size_t)gq * T * 256; E.ldc = 256; E.ACT = 4; }
                    else { g.A = WKV + (size_t)(768 + gq * 256) * 1024; g.Bt = HKV; g.lda = 1024; g.ldb = d * 1024; g.dilA = 0; g.dilB = d; S.init(256, T, G, (bid + (ci & 1) * 128) % G);
                        E.O = (bf16_t*)(ws + WS_VT) + (size_t)gq * 256 * T; E.ldc = (size_t)T; E.ACT = 3; }
                } else {
                    g.A = (const bf16_t*)(ws + WS_HB); g.Bt = (const bf16_t*)(ws + WS_WQB) + (size_t)l * 4096 * 1024; g.lda = 1024; g.ldb = 1024; g.dilA = 0; g.dilB = 0; E.ldc = 1024;
                    E.O = (bf16_t*)(ws + WS_QO); E.O2 = (bf16_t*)(ws + WS_ZS); E.ACT = 6;
                    S.init(T, 4096, G, bid);
                }
                pg8::gemm_phase<EpiBf16>(wv, lds, g, S, E);
            } } }
        else if (kind == 9 || kind == 10) { if (PH_MASK & 256) attn_phase(wv, p, lds, l, kind == 10 ? 1 : 0); }
        }
        if (ph + 1 < NPH) GSYNC();
    }
}

extern "C" void kernel_launch(void* const* d_in, const int* in_sizes, int n_in, void* d_out, int out_size, void* d_ws, size_t ws_size, hipStream_t stream) {
    static int grid = 0;
    if (grid == 0) {
        if (n_in != 21 || ws_size < WS_END) { fprintf(stderr, "kernel_launch: unexpected n_in %d / ws_size %zu (need %zu)\n", n_in, ws_size, (size_t)WS_END); grid = -1; return; }
        int dev = 0, cus = 0, per_cu = 0;
        hipGetDevice(&dev); hipDeviceGetAttribute(&cus, hipDeviceAttributeMultiprocessorCount, dev);
        if (hipFuncSetAttribute((const void*)yoco_fwd, hipFuncAttributeMaxDynamicSharedMemorySize, LDS_BYTES) != hipSuccess) { fprintf(stderr, "kernel_launch: hipFuncSetAttribute failed\n"); grid = -1; return; }
        hipOccupancyMaxActiveBlocksPerMultiprocessor(&per_cu, (const void*)yoco_fwd, 512, LDS_BYTES);
        if (per_cu < 1) { fprintf(stderr, "kernel_launch: occupancy query says %d blocks per CU\n", per_cu); per_cu = 1; }
        (void)hipGetLastError();
        grid = cus;
    }
    if (grid < 0) return;
    Params p{};
    for (int i = 0; i < 21; ++i) p.in[i] = (const float*)d_in[i];
    p.out = (float*)d_out; p.ws = (unsigned char*)d_ws; p.never = 0; p.pad = 0;
    if (hipMemsetAsync(d_ws, 0, XCD_BAR_WORDS * 4, stream) != hipSuccess) { fprintf(stderr, "kernel_launch: memset failed\n"); return; }
    void* args[] = {&p};
    hipError_t e = hipLaunchCooperativeKernel((const void*)yoco_fwd, dim3(grid), dim3(512), args, LDS_BYTES, stream);
    if (e != hipSuccess) fprintf(stderr, "cooperative launch failed: %s (grid %d)\n", hipGetErrorString(e), grid);
}
```
